# Optimizing an MI355X kernel written in HIP

```python
import jax, jax.numpy as jnp
from jax import lax
import numpy as np

D_MODEL = 1024
BATCH = 8
SEQ = 4096
DEPTH = 4

N_BRANCH = 4
BRANCH_WIDTH = 512
EPS = 1e-6
Q_BLOCK = 128
GM_GROUPS = 4
GM_CHUNK = 128
GM_GROUP_DIM = BRANCH_WIDTH // GM_GROUPS
DSA_HEADS = 4
DSA_HEAD_DIM = BRANCH_WIDTH // DSA_HEADS
DSA_LATENT = 128
IDX_HEADS = 4
IDX_DIM = 64
TOPK_MAX = 256
CONV_WIDTH = 3
FOX_HEADS = 4
FOX_HEAD_DIM = BRANCH_WIDTH // FOX_HEADS

W = BRANCH_WIDTH
IN_SPLITS = (
    W, W, W,
    W, DSA_LATENT, IDX_HEADS * IDX_DIM, IDX_DIM, IDX_HEADS, W,
    W, W, W, W,
    W, W, W, FOX_HEADS, W,
    N_BRANCH * D_MODEL,
)
IN_WIDTH = sum(IN_SPLITS)

kernel_name = "hybrid_parallel_gated_mixers"


def rms_norm(x, g):
    xf = x.astype(jnp.float32)
    y = xf * lax.rsqrt(jnp.mean(xf * xf, axis=-1, keepdims=True) + EPS)
    return (y * g.astype(jnp.float32)).astype(x.dtype)


def layer_norm(x, g, b):
    xf = x.astype(jnp.float32)
    mu = jnp.mean(xf, axis=-1, keepdims=True)
    var = jnp.mean(jnp.square(xf - mu), axis=-1, keepdims=True)
    y = (xf - mu) * lax.rsqrt(var + EPS)
    return (y * g.astype(jnp.float32) + b.astype(jnp.float32)).astype(x.dtype)


def to_blocks(a):
    b, s = a.shape[0], a.shape[1]
    return jnp.moveaxis(a.reshape(b, s // Q_BLOCK, Q_BLOCK, *a.shape[2:]), 1, 0)


def from_blocks(a):
    nb, b = a.shape[0], a.shape[1]
    return jnp.moveaxis(a, 0, 1).reshape(b, nb * Q_BLOCK, a.shape[-1])


def chunked_spatial_gating(u, v, ln_g, ln_b, w_s, b_s):
    bsz, s, _ = v.shape
    v = layer_norm(v, ln_g, ln_b)
    vc = v.reshape(bsz, s // GM_CHUNK, GM_CHUNK, GM_GROUPS, GM_GROUP_DIM)
    mask = jnp.tril(jnp.ones((GM_CHUNK, GM_CHUNK), dtype=bool))
    w = jnp.where(mask[None], w_s, jnp.zeros_like(w_s))
    mixed = jnp.einsum('gts,bcsge->bctge', w, vc) + jnp.transpose(b_s)[None, None, :, :, None]
    return u * mixed.reshape(bsz, s, W)


def dsa_attention(q, c_kv, q_idx, k_idx, w_idx, kv_g, w_uk, w_uv):
    bsz, s, _ = q.shape
    k_sel = min(TOPK_MAX, s // 4)
    c = rms_norm(c_kv, kv_g)
    qh = q.reshape(bsz, s, DSA_HEADS, DSA_HEAD_DIM)
    q_lat = jnp.einsum('bshd,hld->bshl', qh, w_uk)
    qi = q_idx.reshape(bsz, s, IDX_HEADS, IDX_DIM)
    wi = w_idx * (IDX_HEADS ** -0.5)
    key_pos = jnp.arange(s)
    gather = jax.vmap(lambda cb, ib: cb[ib])

    def block(args):
        qlb, qib, wib, blk = args
        pos_q = blk * Q_BLOCK + jnp.arange(Q_BLOCK)
        dots = jnp.einsum('bqhd,bsd->bqhs', qib, k_idx).astype(jnp.float32) * (IDX_DIM ** -0.5)
        score = jnp.einsum('bqh,bqhs->bqs', wib.astype(jnp.float32), jax.nn.relu(dots))
        causal = key_pos[None, :] <= pos_q[:, None]
        score = jnp.where(causal[None], score, -jnp.inf)
        _, idx = lax.top_k(score, k_sel)
        valid = idx <= pos_q[None, :, None]
        c_sel = gather(c, idx)
        logits = jnp.einsum('bqhl,bqkl->bqhk', qlb, c_sel).astype(jnp.float32) * (DSA_HEAD_DIM ** -0.5)
        logits = jnp.where(valid[:, :, None, :], logits, -jnp.inf)
        p = jax.nn.softmax(logits, axis=-1).astype(c.dtype)
        o_lat = jnp.einsum('bqhk,bqkl->bqhl', p, c_sel)
        o = jnp.einsum('bqhl,hld->bqhd', o_lat, w_uv)
        return o.reshape(bsz, Q_BLOCK, W)

    nb = s // Q_BLOCK
    out = lax.map(block, (to_blocks(q_lat), to_blocks(qi), to_blocks(wi), jnp.arange(nb)))
    return from_blocks(out)


def short_gated_conv(b_gate, c_gate, x_in, conv_w):
    s = x_in.shape[1]
    y = c_gate * x_in
    yp = jnp.pad(y, ((0, 0), (CONV_WIDTH - 1, 0), (0, 0)))
    conv = conv_w[0] * yp[:, 0:s]
    for j in range(1, CONV_WIDTH):
        conv = conv + conv_w[j] * yp[:, j:j + s]
    return b_gate * conv


def forgetting_attention(q, k, v, f_logit, b_f):
    bsz, s, _ = q.shape
    qh = q.reshape(bsz, s, FOX_HEADS, FOX_HEAD_DIM)
    kh = k.reshape(bsz, s, FOX_HEADS, FOX_HEAD_DIM)
    vh = v.reshape(bsz, s, FOX_HEADS, FOX_HEAD_DIM)
    cum = jnp.cumsum(jax.nn.log_sigmoid((f_logit + b_f).astype(jnp.float32)), axis=1)
    cum_k = jnp.transpose(cum, (0, 2, 1))
    key_pos = jnp.arange(s)

    def block(args):
        qb, cq, blk = args
        pos_q = blk * Q_BLOCK + jnp.arange(Q_BLOCK)
        logits = jnp.einsum('bqhd,bshd->bhqs', qb, kh).astype(jnp.float32) * (FOX_HEAD_DIM ** -0.5)
        logits = logits + jnp.transpose(cq, (0, 2, 1))[..., None] - cum_k[:, :, None, :]
        logits = jnp.where((key_pos[None, :] <= pos_q[:, None])[None, None], logits, -jnp.inf)
        p = jax.nn.softmax(logits, axis=-1).astype(vh.dtype)
        o = jnp.einsum('bhqs,bshd->bqhd', p, vh)
        return o.reshape(bsz, Q_BLOCK, W)

    nb = s // Q_BLOCK
    out = lax.map(block, (to_blocks(qh), to_blocks(cum), jnp.arange(nb)))
    return from_blocks(out)


def hybrid_layer(x, norm_g, w_in, gm_ln_g, gm_ln_b, gm_w_s, gm_b_s, dsa_kv_g, dsa_w_uk, dsa_w_uv,
                 conv_w, fox_b_f, w_branch, w_out):
    bsz, s, d = x.shape
    h = rms_norm(x, norm_g)
    proj = h @ w_in
    points = [int(p) for p in np.cumsum(np.array(IN_SPLITS))[:-1]]
    (a_u, a_v, a_z,
     b_q, b_c, b_qi, b_ki, b_wi, b_z,
     c_b, c_c, c_x, c_z,
     d_q, d_k, d_v, d_f, d_z,
     gates) = jnp.split(proj, points, axis=-1)
    y_a = chunked_spatial_gating(a_u, a_v, gm_ln_g, gm_ln_b, gm_w_s, gm_b_s) * jax.nn.silu(a_z)
    y_b = dsa_attention(b_q, b_c, b_qi, b_ki, b_wi, dsa_kv_g, dsa_w_uk, dsa_w_uv) * jax.nn.silu(b_z)
    y_c = short_gated_conv(c_b, c_c, c_x, conv_w) * jax.nn.silu(c_z)
    y_d = forgetting_attention(d_q, d_k, d_v, d_f, fox_b_f) * jax.nn.silu(d_z)
    ys = jnp.stack([y_a, y_b, y_c, y_d], axis=0)
    branch_d = jnp.einsum('nbsw,nwd->bsnd', ys, w_branch)
    g = jax.nn.sigmoid(gates.reshape(bsz, s, N_BRANCH, d))
    merged = jnp.sum(g * branch_d, axis=2)
    return x + merged @ w_out


def setup_inputs(seed: int = 0) -> dict:
    key = jax.random.key(seed)
    ks = jax.random.split(key, 16)
    f32 = jnp.float32
    nrm = lambda k, shp, sc: jax.random.normal(k, shp, f32) * sc
    return {
        'x': nrm(ks[0], (BATCH, SEQ, D_MODEL), 1.0),
        'norm_g': 1.0 + nrm(ks[1], (DEPTH, D_MODEL), 0.05),
        'w_in': nrm(ks[2], (DEPTH, D_MODEL, IN_WIDTH), D_MODEL ** -0.5),
        'gm_ln_g': 1.0 + nrm(ks[3], (DEPTH, W), 0.05),
        'gm_ln_b': nrm(ks[4], (DEPTH, W), 0.02),
        'gm_w_s': nrm(ks[5], (DEPTH, GM_GROUPS, GM_CHUNK, GM_CHUNK), GM_CHUNK ** -0.5),
        'gm_b_s': 1.0 + nrm(ks[6], (DEPTH, GM_GROUPS, GM_CHUNK), 0.1),
        'dsa_kv_g': 1.0 + nrm(ks[7], (DEPTH, DSA_LATENT), 0.05),
        'dsa_w_uk': nrm(ks[8], (DEPTH, DSA_HEADS, DSA_LATENT, DSA_HEAD_DIM), DSA_LATENT ** -0.5),
        'dsa_w_uv': nrm(ks[9], (DEPTH, DSA_HEADS, DSA_LATENT, DSA_HEAD_DIM), DSA_LATENT ** -0.5),
        'conv_w': nrm(ks[10], (DEPTH, CONV_WIDTH, W), CONV_WIDTH ** -0.5),
        'fox_b_f': jax.random.uniform(ks[11], (DEPTH, FOX_HEADS), f32, minval=1.0, maxval=4.0),
        'w_branch': nrm(ks[12], (DEPTH, N_BRANCH, W, D_MODEL), W ** -0.5),
        'w_out': nrm(ks[13], (DEPTH, D_MODEL, D_MODEL), 0.5 * D_MODEL ** -0.5),
        'final_g': 1.0 + nrm(ks[14], (D_MODEL,), 0.05),
    }


def reference(x, norm_g, w_in, gm_ln_g, gm_ln_b, gm_w_s, gm_b_s, dsa_kv_g, dsa_w_uk, dsa_w_uv,
              conv_w, fox_b_f, w_branch, w_out, final_g):
    h = x
    for l in range(DEPTH):
        h = hybrid_layer(h, norm_g[l], w_in[l], gm_ln_g[l], gm_ln_b[l], gm_w_s[l], gm_b_s[l],
                         dsa_kv_g[l], dsa_w_uk[l], dsa_w_uv[l], conv_w[l], fox_b_f[l],
                         w_branch[l], w_out[l])
    return rms_norm(h, final_g)
```

```cpp
#include <hip/hip_runtime.h>
#include <hip/hip_cooperative_groups.h>
#include <cstdio>
namespace cg = cooperative_groups;

#define LAS __attribute__((address_space(3)))
typedef unsigned short u16;
typedef short bf16x8 __attribute__((ext_vector_type(8)));
typedef float f32x4 __attribute__((ext_vector_type(4)));
typedef float f32x16 __attribute__((ext_vector_type(16)));
typedef unsigned u32x4 __attribute__((ext_vector_type(4)));
typedef unsigned u32x2 __attribute__((ext_vector_type(2)));
typedef float f32x2 __attribute__((ext_vector_type(2)));

#ifndef FUSED
#define FUSED 1
#endif

constexpr int DM = 1024, SEQ = 4096, DEPTH = 4;
constexpr int MG = 16384, BG = 4, NGRP = 2;
constexpr int NP = 11264, INW = 11208;
constexpr int C_AU = 0, C_AV = 512, C_AZ = 1024, C_QL = 1536, C_BC = 2048, C_QI = 2176, C_KI = 2432, C_WI = 2496, C_DF = 2500,
              C_BZ = 2560, C_CB = 3072, C_CC = 3584, C_CX = 4096, C_CZ = 4608, C_DQ = 5120, C_DK = 5632, C_DV = 6144, C_DZ = 6656, C_G = 7168;
constexpr int LDS_BYTES = 147456 + 64, XB_ST_OFF = 147456, ITEM_OFF = 131776;
constexpr int NK = 5;
constexpr int NSTEP = DEPTH * NGRP * NK + 1;
constexpr float EPS = 1e-6f;

struct Params {
    const float *x, *norm_g, *w_in, *gm_ln_g, *gm_ln_b, *gm_w_s, *gm_b_s, *dsa_kv_g, *dsa_w_uk, *dsa_w_uv, *conv_w, *fox_b_f, *w_branch, *w_out, *final_g;
    float* out;
    u16 *Wt, *Wb, *Wo, *WuvT, *hbuf, *proj, *ybuf, *vT, *kiP;
    unsigned* ctr; unsigned* bar; unsigned char* gq;
};

__device__ __forceinline__ float bf2f(u16 b) { return __uint_as_float(((unsigned)b) << 16); }
__device__ __forceinline__ float bflo(unsigned w) { return __uint_as_float(w << 16); }
__device__ __forceinline__ float bfhi(unsigned w) { return __uint_as_float(w & 0xffff0000u); }
__device__ __forceinline__ unsigned cvtpk(float lo, float hi) { unsigned r; asm volatile("v_cvt_pk_bf16_f32 %0, %1, %2" : "=v"(r) : "v"(lo), "v"(hi)); return r; }
__device__ __forceinline__ u16 f2bf(float f) { return (u16)(cvtpk(f, 0.f) & 0xffffu); }
__device__ __forceinline__ float sigmoidf_(float x) { return __builtin_amdgcn_rcpf(1.f + __expf(-x)); }
__device__ __forceinline__ float siluf_(float x) { return x * sigmoidf_(x); }
__device__ __forceinline__ int opq(int x) { asm volatile("" : "+v"(x)); return x; }
__device__ __forceinline__ float wave_sum(float v) { for (int o = 32; o >= 1; o >>= 1) v += __shfl_xor(v, o); return v; }

namespace pg8 {
constexpr int BM = 256, BK = 64, HALF = 128, HTB = HALF * BK * 2, NXCD = 8, WGM = 4;
__device__ __forceinline__ int lds_byte(int r, int c) { const int st = (r >> 4) * 2 + (c >> 5), rr = r & 15, cc = c & 31, ob = rr * 64 + cc * 2; return st * 1024 + (ob ^ (((ob >> 9) & 1) << 5)); }
__device__ __forceinline__ int perm32(int rho) { const int n = rho >> 4, i = rho & 15; return 8 * (i >> 2) + 4 * n + (i & 3); }
__device__ __forceinline__ void stage_rc(int b, int& R, int& C) { const int st = b / 1024, sb = b % 1024, swz = sb ^ (((sb >> 9) & 1) << 5); R = (st >> 1) * 16 + swz / 64; C = (st & 1) * 32 + (swz % 64) / 2; }
struct Unit { int pm, pn; };
struct Gemm { const u16* A; const u16* Bt; int M, N, K; int pn_per_grp; size_t a_grp_bytes; };
struct StaticOrder {
    int nM, nN, nwg, G, c;
    __device__ void init(int M, int N, int G_, int c_) { nM = M / BM; nN = N / BM; nwg = nM * nN; G = G_; c = c_; }
    __device__ bool next(int i, Unit& u) const {
        const long L = (long)i * G + c; if (L >= nwg) return false;
        int wgid = (int)L; { const int q = nwg / NXCD, r = nwg % NXCD, xcd = wgid % NXCD, off = wgid / NXCD; wgid = (xcd < r ? xcd * (q + 1) : r * (q + 1) + (xcd - r) * q) + off; }
        const int nig = WGM * nN, gid = wgid / nig, fm = gid * WGM, gsz = (nM - fm) < WGM ? (nM - fm) : WGM;
        u.pm = fm + ((wgid % nig) % gsz); u.pn = (wgid % nig) / gsz;
        if (nN == 44) u.pn = (u.pn + 5 * (int)(L % NXCD)) % 44;
        return true;
    }
};
struct BranchOrder {
    int G, c, ntile;
    __device__ bool next(int i, Unit& u) const { const int tile = c + (i >> 2) * G; if (tile >= ntile) return false; u.pm = tile >> 2; u.pn = (i & 3) * 4 + (tile & 3); return true; }
};
template <class Epi, class Sched>
__device__ __forceinline__ void gemm_phase(LAS unsigned char* lds, const Gemm g, const Sched& S, const Epi& E) {
    const int tid = opq(threadIdx.x), wid = __builtin_amdgcn_readfirstlane(tid >> 6), lane = tid & 63, wr = wid >> 2, wc = wid & 3, fr = lane & 15, fq = lane >> 4;
    const int K = g.K, nt = K / BK;
    unsigned voffA[2], voffB[2];
#pragma unroll
    for (int i = 0; i < 2; ++i) { int R, C; stage_rc(tid * 16 + i * 8192, R, C); const int Rb = Epi::PERM ? ((R & ~31) + perm32(R & 31)) : R;
        voffA[i] = (unsigned)(R * K + C) * 2u; voffB[i] = (unsigned)(Rb * K + C) * 2u; }
    const size_t kstep = (size_t)(BK * 2);
    const size_t hstep = (size_t)HALF * K * 2;
    const size_t tstep = 2 * hstep;
    const unsigned ldsw = (unsigned)wid * 1024u;
    const int aoff = lds_byte(wr * 64 + fr, fq * 8), boff = lds_byte(wc * 32 + fr, fq * 8);
#define PG8_SA(b, h) (((b) * 2 + (h)) * HTB)
#define PG8_SB(b, h) ((4 + (b) * 2 + (h)) * HTB)
#define PG8_STAGE(bufoff, gbase, voff) do { _Pragma("unroll") for (int _i = 0; _i < 2; ++_i) \
        __builtin_amdgcn_global_load_lds((const unsigned*)((const char*)(gbase) + (voff)[_i]), (LAS unsigned*)(lds + (bufoff) + ldsw + _i * 8192), 16, 0, 0); } while (0)
#define PG8_LDA(dst, b, h) do { _Pragma("unroll") for (int m = 0; m < 4; ++m) _Pragma("unroll") for (int k = 0; k < 2; ++k) dst[m][k] = *(const LAS bf16x8*)(lds + PG8_SA(b, h) + aoff + m * 2048 + k * 1024); } while (0)
#define PG8_LDB(dst, b, h) do { _Pragma("unroll") for (int n = 0; n < 2; ++n) _Pragma("unroll") for (int k = 0; k < 2; ++k) dst[n][k] = *(const LAS bf16x8*)(lds + PG8_SB(b, h) + boff + n * 2048 + k * 1024); } while (0)
#define PG8_MMA(ai, bj, At, Bt) do { __builtin_amdgcn_s_setprio(1); _Pragma("unroll") for (int m = 0; m < 4; ++m) _Pragma("unroll") for (int n = 0; n < 2; ++n) _Pragma("unroll") for (int k = 0; k < 2; ++k) \
        acc[ai][bj][m][n] = __builtin_amdgcn_mfma_f32_16x16x32_bf16(Bt[n][k], At[m][k], acc[ai][bj][m][n], 0, 0, 0); __builtin_amdgcn_s_setprio(0); } while (0)
#define PG8_WAIT_V(n) asm volatile("s_waitcnt vmcnt(" #n ")" ::: "memory")
#define PG8_WAIT_L(n) asm volatile("s_waitcnt lgkmcnt(" #n ")" ::: "memory")
#define PG8_BAR __builtin_amdgcn_s_barrier()
#define PG8_SCHED __builtin_amdgcn_sched_barrier(0)
    Unit cur, nxt; int ui = 0;
    if (!S.next(0, cur)) return;
    f32x4 acc[2][2][4][2];
#pragma unroll
    for (int a = 0; a < 2; ++a)
#pragma unroll
        for (int b = 0; b < 2; ++b)
#pragma unroll
            for (int m = 0; m < 4; ++m)
#pragma unroll
                for (int n = 0; n < 2; ++n) acc[a][b][m][n] = (f32x4){0.f, 0.f, 0.f, 0.f};
    bf16x8 At[4][2], B0[2][2], B1[2][2];
    const char* cA = (const char*)g.A + (size_t)cur.pm * tstep + (size_t)(cur.pn / g.pn_per_grp) * g.a_grp_bytes; const char* cB = (const char*)g.Bt + (size_t)cur.pn * tstep;
    PG8_STAGE(PG8_SB(0, 0), cB, voffB); PG8_STAGE(PG8_SA(0, 0), cA, voffA); PG8_STAGE(PG8_SB(0, 1), cB + hstep, voffB); PG8_STAGE(PG8_SA(0, 1), cA + hstep, voffA);
    if (wr == 1) PG8_BAR;
    PG8_WAIT_V(4); PG8_BAR;
    PG8_STAGE(PG8_SB(1, 0), cB + kstep, voffB); PG8_STAGE(PG8_SA(1, 0), cA + kstep, voffA); PG8_STAGE(PG8_SB(1, 1), cB + hstep + kstep, voffB);
    PG8_WAIT_V(6); PG8_BAR;
    for (;;) {
        const bool has_next = S.next(ui + 1, nxt);
        const char* nA = has_next ? (const char*)g.A + (size_t)nxt.pm * tstep + (size_t)(nxt.pn / g.pn_per_grp) * g.a_grp_bytes : cA; const char* nB = has_next ? (const char*)g.Bt + (size_t)nxt.pn * tstep : cB;
        for (int t = 0; t < nt; t += 2) {
            const bool last = (t == nt - 2);
            const char* a1 = cA + (size_t)(t + 1) * kstep;
            const char* a2 = last ? nA : cA + (size_t)(t + 2) * kstep; const char* b2 = last ? nB : cB + (size_t)(t + 2) * kstep;
            const char* a3 = a2 + kstep; const char* b3 = b2 + kstep;
            PG8_LDB(B0, 0, 0); PG8_SCHED; PG8_LDA(At, 0, 0); PG8_STAGE(PG8_SA(1, 1), a1 + hstep, voffA);
            PG8_WAIT_L(8); PG8_BAR; PG8_WAIT_L(0); PG8_MMA(0, 0, At, B0); PG8_BAR; PG8_SCHED;
            PG8_LDB(B1, 0, 1); PG8_STAGE(PG8_SB(0, 0), b2, voffB);
            PG8_BAR; PG8_WAIT_L(0); PG8_MMA(0, 1, At, B1); PG8_BAR;
            PG8_LDA(At, 0, 1); PG8_STAGE(PG8_SA(0, 0), a2, voffA);
            PG8_BAR; PG8_WAIT_L(0); PG8_MMA(1, 0, At, B0); PG8_BAR; PG8_SCHED;
            PG8_STAGE(PG8_SB(0, 1), b2 + hstep, voffB);
            PG8_WAIT_V(6); PG8_BAR; PG8_MMA(1, 1, At, B1); PG8_BAR;
            PG8_LDB(B0, 1, 0); PG8_SCHED; PG8_LDA(At, 1, 0); PG8_STAGE(PG8_SA(0, 1), a2 + hstep, voffA);
            PG8_WAIT_L(8); PG8_BAR; PG8_WAIT_L(0); PG8_MMA(0, 0, At, B0); PG8_BAR; PG8_SCHED;
            PG8_LDB(B1, 1, 1); PG8_STAGE(PG8_SB(1, 0), b3, voffB);
            PG8_BAR; PG8_WAIT_L(0); PG8_MMA(0, 1, At, B1); PG8_BAR;
            PG8_LDA(At, 1, 1); PG8_STAGE(PG8_SA(1, 0), a3, voffA);
            PG8_BAR; PG8_WAIT_L(0); PG8_MMA(1, 0, At, B0); PG8_BAR; PG8_SCHED;
            PG8_STAGE(PG8_SB(1, 1), b3 + hstep, voffB);
            PG8_WAIT_V(6); PG8_BAR; PG8_MMA(1, 1, At, B1); PG8_BAR;
        }
        E(acc, cur, wr, wc, fr, fq);
        if (!has_next) break;
        if (!E.keep(cur)) {
#pragma unroll
        for (int a = 0; a < 2; ++a)
#pragma unroll
            for (int b = 0; b < 2; ++b)
#pragma unroll
                for (int m = 0; m < 4; ++m)
#pragma unroll
                    for (int n = 0; n < 2; ++n) acc[a][b][m][n] = (f32x4){0.f, 0.f, 0.f, 0.f};
        }
        cur = nxt; cA = nA; cB = nB; ++ui;
    }
    PG8_WAIT_V(0);
    if (wr == 0) PG8_BAR;
    PG8_BAR;
#undef PG8_SA
#undef PG8_SB
#undef PG8_STAGE
#undef PG8_LDA
#undef PG8_LDB
#undef PG8_MMA
#undef PG8_WAIT_V
#undef PG8_WAIT_L
#undef PG8_BAR
#undef PG8_SCHED
}
}

struct EpiG1 {
    static constexpr bool PERM = true;
    __device__ __forceinline__ bool keep(const pg8::Unit&) const { return false; }
    u16* proj; u16* vT; u16* kiP; unsigned char* gq;
    __device__ __forceinline__ void operator()(f32x4 (&acc)[2][2][4][2], const pg8::Unit& u, int wr, int wc, int fr, int fq) const {
        const int row0 = u.pm * 256 + wr * 64 + fr, cin = wc * 32 + 8 * fq, col0 = u.pn * 256 + cin;
        if (u.pn == 24 || u.pn == 25) {
#pragma unroll
            for (int ai = 0; ai < 2; ++ai)
#pragma unroll
                for (int m = 0; m < 4; ++m) {
                    const int r = row0 + ai * 128 + m * 16, bl = r >> 12, s = r & 4095;
#pragma unroll
                    for (int bj = 0; bj < 2; ++bj)
#pragma unroll
                        for (int n = 0; n < 2; ++n) {
                            const int cv = (u.pn - 24) * 256 + bj * 128 + cin + 4 * n;
                            u16* dst = vT + ((size_t)(bl * 512 + cv)) * 4096 + s;
#pragma unroll
                            for (int j = 0; j < 4; ++j) dst[(size_t)j * 4096] = f2bf(acc[ai][bj][m][n][j]);
                        }
                }
            return;
        }
        if (u.pn >= 28) {
#pragma unroll
            for (int ai = 0; ai < 2; ++ai)
#pragma unroll
                for (int m = 0; m < 4; ++m) {
                    unsigned char* gp = gq + (size_t)(row0 + ai * 128 + m * 16) * 4096 + (u.pn - 28) * 256 + cin;
#pragma unroll
                    for (int bj = 0; bj < 2; ++bj) { unsigned w2[2];
#pragma unroll
                        for (int n = 0; n < 2; ++n) {
                            const f32x4 v = acc[ai][bj][m][n];
                            const unsigned b0 = (unsigned)(sigmoidf_(v[0]) * 255.f + 0.5f), b1 = (unsigned)(sigmoidf_(v[1]) * 255.f + 0.5f),
                                           b2 = (unsigned)(sigmoidf_(v[2]) * 255.f + 0.5f), b3 = (unsigned)(sigmoidf_(v[3]) * 255.f + 0.5f);
                            w2[n] = b0 | (b1 << 8) | (b2 << 16) | (b3 << 24);
                        }
                        u32x2 o = {w2[0], w2[1]}; *(u32x2*)(gp + bj * 128) = o; }
                }
            return;
        }
#pragma unroll
        for (int ai = 0; ai < 2; ++ai)
#pragma unroll
            for (int m = 0; m < 4; ++m) {
                u16* rowp = proj + (size_t)(row0 + ai * 128 + m * 16) * NP + col0;
#pragma unroll
                for (int bj = 0; bj < 2; ++bj) {
                    const f32x4 v0 = acc[ai][bj][m][0], v1 = acc[ai][bj][m][1];
                    u32x4 o = {cvtpk(v0[0], v0[1]), cvtpk(v0[2], v0[3]), cvtpk(v1[0], v1[1]), cvtpk(v1[2], v1[3])};
                    *(u32x4*)(rowp + bj * 128) = o;
                    if (u.pn == 9 && bj == 1 && wc < 2) {
                        const int r = row0 + ai * 128 + m * 16, bl = r >> 12, key = r & 4095;
                        *(u32x4*)(kiP + (((((size_t)bl * 128 + (key >> 5)) * 4 + (cin >> 4)) * 64) + ((cin >> 3) & 1) * 32 + (key & 31)) * 8) = o;
                    }
                }
            }
    }
};
struct EpiG2 {
    static constexpr bool PERM = true;
    const unsigned char* gq; u16* hbuf;
    __device__ __forceinline__ bool keep(const pg8::Unit& u) const { return u.pn < 12; }
    __device__ __forceinline__ void operator()(f32x4 (&acc)[2][2][4][2], const pg8::Unit& u, int wr, int wc, int fr, int fq) const {
        const int row0 = u.pm * 256 + wr * 64 + fr, cin = wc * 32 + 8 * fq; const bool last = (u.pn >= 12);
#pragma unroll
        for (int ai = 0; ai < 2; ++ai) {
            u32x2 ga[4][2], gb[4][2];
#pragma unroll
            for (int m = 0; m < 4; ++m) {
                const unsigned char* gp = gq + (size_t)(row0 + ai * 128 + m * 16) * 4096 + u.pn * 256 + cin;
#pragma unroll
                for (int bj = 0; bj < 2; ++bj) { ga[m][bj] = *(const u32x2*)(gp + bj * 128);
                    gb[m][bj] = last ? (u32x2){0x01010101u, 0x01010101u} : *(const u32x2*)(gp + 1024 + bj * 128); }
            }
#pragma unroll
            for (int m = 0; m < 4; ++m) {
                u16* op = hbuf + (size_t)(row0 + ai * 128 + m * 16) * DM + (u.pn & 3) * 256 + cin;
#pragma unroll
                for (int bj = 0; bj < 2; ++bj) {
                    f32x4 vv[2];
#pragma unroll
                    for (int n = 0; n < 2; ++n) {
                        const unsigned a4 = ga[m][bj][n], b4 = gb[m][bj][n]; f32x4 v = acc[ai][bj][m][n];
#pragma unroll
                        for (int j = 0; j < 4; ++j) { const float ga_ = fmaxf((float)((a4 >> (8 * j)) & 255u), 1.f), gb_ = fmaxf((float)((b4 >> (8 * j)) & 255u), 1.f);
                            v[j] *= last ? ga_ * (1.f / 255.f) : ga_ * __builtin_amdgcn_rcpf(gb_); }
                        vv[n] = v; if (!last) acc[ai][bj][m][n] = v;
                    }
                    if (last) { u32x4 o = {cvtpk(vv[0][0], vv[0][1]), cvtpk(vv[0][2], vv[0][3]), cvtpk(vv[1][0], vv[1][1]), cvtpk(vv[1][2], vv[1][3])}; *(u32x4*)(op + bj * 128) = o; }
                }
            }
        }
    }
};
struct EpiG3 {
    static constexpr bool PERM = true;
    __device__ __forceinline__ bool keep(const pg8::Unit&) const { return false; }
    const float* resid; float* out; int tok0;
    __device__ __forceinline__ void operator()(f32x4 (&acc)[2][2][4][2], const pg8::Unit& u, int wr, int wc, int fr, int fq) const {
        const int row0 = tok0 + u.pm * 256 + wr * 64 + fr, col0 = u.pn * 256 + wc * 32 + 8 * fq;
#pragma unroll
        for (int ai = 0; ai < 2; ++ai) {
            f32x4 rv[4][2][2];
#pragma unroll
            for (int m = 0; m < 4; ++m) { const size_t ro = (size_t)(row0 + ai * 128 + m * 16) * DM + col0;
#pragma unroll
                for (int bj = 0; bj < 2; ++bj)
#pragma unroll
                    for (int n = 0; n < 2; ++n) rv[m][bj][n] = *(const f32x4*)(resid + ro + bj * 128 + n * 4); }
#pragma unroll
            for (int m = 0; m < 4; ++m) { const size_t ro = (size_t)(row0 + ai * 128 + m * 16) * DM + col0;
#pragma unroll
                for (int bj = 0; bj < 2; ++bj)
#pragma unroll
                    for (int n = 0; n < 2; ++n) *(f32x4*)(out + ro + bj * 128 + n * 4) = rv[m][bj][n] + acc[ai][bj][m][n]; }
        }
    }
};

__device__ __forceinline__ int win_src(int j) {
    if (j < 1536) return j;
    if (j < 2048) return -2;
    if (j < 2500) return j;
    if (j < 2504) return 6596 + (j - 2500);
    if (j < 2560) return -1;
    if (j < 3072) return 2500 + (j - 2560);
    if (j < 5120) return 3012 + (j - 3072);
    if (j < 6656) return 5060 + (j - 5120);
    if (j < 7168) return 6600 + (j - 6656);
    return 7112 + (j - 7168);
}
__device__ __forceinline__ void tr_tile(const float* src, int ldS, u16* dst, int ldD, int n0, int k0, bool wmap, const float* rs, LAS float* tile) {
    const int tid = opq(threadIdx.x);
    { const int nn = tid & 63, kr = tid >> 6; int sc = n0 + nn; if (wmap) sc = win_src(sc);
#pragma unroll
      for (int i = 0; i < 8; ++i) { const int k = kr + 8 * i; float v = 0.f; if (sc >= 0) { v = src[(size_t)(k0 + k) * ldS + sc]; if (rs) v *= rs[k0 + k]; } tile[k * 65 + nn] = v; } }
    __syncthreads();
    { const int kk = (tid & 31) * 2, nr = tid >> 5;
#pragma unroll
      for (int i = 0; i < 4; ++i) { const int n = nr + 16 * i; *(unsigned*)(dst + (size_t)(n0 + n) * ldD + k0 + kk) = cvtpk(tile[kk * 65 + n], tile[(kk + 1) * 65 + n]); } }
    __syncthreads();
}
__device__ __forceinline__ void step_prep(const Params& p, int l, LAS unsigned char* lds) {
    LAS float* tile = (LAS float*)lds;
    const int nb = gridDim.x, b = blockIdx.x, tid = opq(threadIdx.x);
    for (int it = b; it < 3856; it += nb) {
        if (it < 2816) { const int ntile = it / 16, kt = it % 16; if (ntile >= 24 && ntile < 32) continue;
            tr_tile(p.w_in + (size_t)l * DM * INW, INW, p.Wt, DM, ntile * 64, kt * 64, true, nullptr, tile); }
        else if (it < 3328) { const int j = it - 2816, n = j / 128, r = j % 128, dt = r / 8, wt = r % 8;
            tr_tile(p.w_branch + ((size_t)(l * 4 + n)) * 512 * DM, DM, p.Wb + (size_t)n * DM * 512, 512, dt * 64, wt * 64, false, nullptr, tile); }
        else if (it < 3584) { const int j = it - 3328, ntile = j / 16, kt = j % 16;
            tr_tile(p.w_out + (size_t)l * DM * DM, DM, p.Wo, DM, ntile * 64, kt * 64, false, nullptr, tile); }
        else if (it < 3600) { const int j = it - 3584, h = j / 4, dt = (j % 4) / 2, lt = j % 2;
            tr_tile(p.dsa_w_uv + ((size_t)(l * 4 + h)) * 128 * 128, 128, p.WuvT + (size_t)h * 128 * 128, 128, dt * 64, lt * 64, false, p.dsa_kv_g + l * 128, tile); }
        else { const int j = it - 3600, h = j & 3, kb = j >> 2;
            LAS float* wuk = (LAS float*)lds;
            for (int i = tid; i < 128 * 128; i += 512) wuk[(i >> 7) * 129 + (i & 127)] = p.dsa_w_uk[((size_t)(l * 4 + h)) * 16384 + i];
            __syncthreads();
            const int lat = tid & 127, kq = tid >> 7; const float gk = p.dsa_kv_g[l * 128 + lat];
            for (int kk = 0; kk < 4; ++kk) { const int k = kb * 16 + kq * 4 + kk; const float* wr_ = p.w_in + ((size_t)l * DM + k) * INW + 1536 + h * 128;
                float a = 0.f;
#pragma unroll 8
                for (int d = 0; d < 128; ++d) a += wr_[d] * wuk[lat * 129 + d];
                p.Wt[(size_t)(C_QL + h * 128 + lat) * DM + k] = f2bf(a * gk); }
            __syncthreads(); }
    }
}
__device__ __forceinline__ void step_norm(const Params& p, int l, int g) {
    const float* src = (l == 0) ? p.x : p.out; const float* gw = p.norm_g + l * DM;
    const int tidq = opq(threadIdx.x), wid = tidq >> 6, lane = tidq & 63, gwv = blockIdx.x * 8 + wid, nwv = gridDim.x * 8;
    for (int r = gwv; r < MG; r += nwv) {
        const float* xr = src + (size_t)(g * MG + r) * DM; f32x4 v[4]; float ss = 0.f;
#pragma unroll
        for (int i = 0; i < 4; ++i) { v[i] = *(const f32x4*)(xr + lane * 4 + 256 * i); ss += v[i][0] * v[i][0] + v[i][1] * v[i][1] + v[i][2] * v[i][2] + v[i][3] * v[i][3]; }
        ss = wave_sum(ss); const float rstd = rsqrtf(ss * (1.f / DM) + EPS);
#pragma unroll
        for (int i = 0; i < 4; ++i) { const f32x4 gv = *(const f32x4*)(gw + lane * 4 + 256 * i);
            u32x2 o = {cvtpk(v[i][0] * rstd * gv[0], v[i][1] * rstd * gv[1]), cvtpk(v[i][2] * rstd * gv[2], v[i][3] * rstd * gv[3])};
            *(u32x2*)(p.hbuf + (size_t)r * DM + lane * 4 + 256 * i) = o; }
    }
}
__device__ __forceinline__ void step_final(const Params& p) {
    const int tidq = opq(threadIdx.x), wid = tidq >> 6, lane = tidq & 63, gwv = blockIdx.x * 8 + wid, nwv = gridDim.x * 8;
    for (int r = gwv; r < 32768; r += nwv) {
        float* xr = p.out + (size_t)r * DM; f32x4 v[4]; float ss = 0.f;
#pragma unroll
        for (int i = 0; i < 4; ++i) { v[i] = *(const f32x4*)(xr + lane * 4 + 256 * i); ss += v[i][0] * v[i][0] + v[i][1] * v[i][1] + v[i][2] * v[i][2] + v[i][3] * v[i][3]; }
        ss = wave_sum(ss); const float rstd = rsqrtf(ss * (1.f / DM) + EPS);
#pragma unroll
        for (int i = 0; i < 4; ++i) { const f32x4 gv = *(const f32x4*)(p.final_g + lane * 4 + 256 * i); *(f32x4*)(xr + lane * 4 + 256 * i) = v[i] * rstd * gv; }
    }
}
__device__ __forceinline__ void step_merge(const Params& p) {
    const int gt = blockIdx.x * 512 + opq(threadIdx.x), nth = gridDim.x * 512;
    for (int i = gt; i < MG * 128; i += nth) {
        const int r = i >> 7, c = (i & 127) * 8; const u16* base = p.proj + (size_t)r * NP + c; float s[8];
        { const u32x4 a = *(const u32x4*)base;
#pragma unroll
          for (int e = 0; e < 4; ++e) { s[2 * e] = bflo(a[e]); s[2 * e + 1] = bfhi(a[e]); } }
#pragma unroll
        for (int n = 1; n < 4; ++n) { const u32x4 a = *(const u32x4*)(base + n * 1024);
#pragma unroll
            for (int e = 0; e < 4; ++e) { s[2 * e] += bflo(a[e]); s[2 * e + 1] += bfhi(a[e]); } }
        u32x4 o = {cvtpk(s[0], s[1]), cvtpk(s[2], s[3]), cvtpk(s[4], s[5]), cvtpk(s[6], s[7])};
        *(u32x4*)(p.hbuf + (size_t)r * DM + c) = o;
    }
}

constexpr int D_K0 = 0, D_K1 = 17408, D_V0 = 34816, D_V1 = 53248, D_V2 = 71680, D_CUM = 90112, D_WS = 106496;
__device__ __forceinline__ void item_fox(const Params& p, int l, int bl, int h, int qb, LAS unsigned char* lds) {
    const int tid = opq(threadIdx.x), wid = __builtin_amdgcn_readfirstlane(tid >> 6), lane = tid & 63, c32 = lane & 31, hi = lane >> 5;
    const int nk = (qb + 1) * 256, ntile = nk / 64;
    const u16* prow = p.proj + (size_t)bl * SEQ * NP;
    LAS float* cumL = (LAS float*)(lds + D_CUM); LAS float* wsum = (LAS float*)(lds + D_WS);
    const float LOG2E = 1.4426950408889634f;
    { const float bf = p.fox_b_f[l * 4 + h]; float v[8], tot = 0.f;
#pragma unroll
      for (int i = 0; i < 8; ++i) { const int s = tid * 8 + i; float ls = 0.f;
          if (s < nk) { const float xx = bf2f(prow[(size_t)s * NP + C_DF + h]) + bf; ls = fminf(xx, 0.f) - log1pf(__expf(-fabsf(xx))); }
          tot += ls; v[i] = tot; }
      float incl = tot;
#pragma unroll
      for (int o = 1; o < 64; o <<= 1) { const float y = __shfl_up(incl, o); if (lane >= o) incl += y; }
      if (lane == 63) wsum[wid] = incl;
      __syncthreads();
      float woff = 0.f; for (int w = 0; w < wid; ++w) woff += wsum[w];
      const float base = woff + incl - tot;
#pragma unroll
      for (int i = 0; i < 8; ++i) cumL[tid * 8 + i] = -(base + v[i]) * LOG2E; }
    const int qrow = qb * 256 + wid * 32 + c32;
    bf16x8 Qf[8];
    { const u16* qp = prow + (size_t)qrow * NP + C_DQ + h * 128 + 8 * hi;
#pragma unroll
      for (int ks = 0; ks < 8; ++ks) Qf[ks] = *(const bf16x8*)(qp + ks * 16); }
    const u16* kg = prow + C_DK + h * 128; const u16* vg = p.vT + ((size_t)(bl * 4 + h)) * 128 * 4096;
    u32x4 st[4];
    auto gload = [&](int kt) {
#pragma unroll
        for (int i = 0; i < 2; ++i) { const int c = tid + 512 * i; st[i] = *(const u32x4*)(kg + (size_t)(kt * 64 + (c >> 4)) * NP + (c & 15) * 8); }
#pragma unroll
        for (int i = 0; i < 2; ++i) { const int c = tid + 512 * i; st[2 + i] = *(const u32x4*)(vg + (size_t)(c >> 3) * 4096 + kt * 64 + (c & 7) * 8); }
    };
    auto vbuf = [&](int kt) -> LAS unsigned char* { const int r = kt % 3; return lds + (r == 0 ? D_V0 : (r == 1 ? D_V1 : D_V2)); };
    auto lstore = [&](int kt) {
        LAS unsigned char* kb = lds + ((kt & 1) ? D_K1 : D_K0); LAS unsigned char* vb = vbuf(kt);
#pragma unroll
        for (int i = 0; i < 2; ++i) { const int c = tid + 512 * i; *(LAS u32x4*)(kb + (c >> 4) * 272 + (c & 15) * 16) = st[i]; }
#pragma unroll
        for (int i = 0; i < 2; ++i) { const int c = tid + 512 * i; *(LAS u32x4*)(vb + (c >> 3) * 144 + (c & 7) * 16) = st[2 + i]; }
    };
    gload(0); lstore(0);
    __syncthreads();
    f32x16 O[4];
#pragma unroll
    for (int i = 0; i < 4; ++i)
#pragma unroll
        for (int r = 0; r < 16; ++r) O[i][r] = 0.f;
    float mrun = -1e30f, lrun = 0.f;
    const int rowA = (c32 & 0x13) | ((c32 & 4) << 1) | ((c32 & 8) >> 1);
    const float C2 = 0.08838834764831845f * LOG2E;
    const int qw_lo = qb * 256 + wid * 32;
    u32x4 Pk[4];
    auto qk_sm = [&](int kt) {
        const int k0 = kt * 64;
        LAS unsigned char* kb = lds + ((kt & 1) ? D_K1 : D_K0);
        f32x16 S0, S1;
#pragma unroll
        for (int r = 0; r < 16; ++r) { S0[r] = 0.f; S1[r] = 0.f; }
#pragma unroll
        for (int ks = 0; ks < 8; ++ks) {
            const bf16x8 a0 = *(const LAS bf16x8*)(kb + rowA * 272 + ks * 32 + hi * 16);
            const bf16x8 a1 = *(const LAS bf16x8*)(kb + (rowA + 32) * 272 + ks * 32 + hi * 16);
            S0 = __builtin_amdgcn_mfma_f32_32x32x16_bf16(a0, Qf[ks], S0, 0, 0, 0);
            S1 = __builtin_amdgcn_mfma_f32_32x32x16_bf16(a1, Qf[ks], S1, 0, 0, 0);
        }
        const int kb0 = k0 + 8 * hi;
#pragma unroll
        for (int q4 = 0; q4 < 4; ++q4) {
            const f32x4 c0 = *(const LAS f32x4*)(cumL + kb0 + (q4 & 1) * 4 + (q4 >> 1) * 16);
            const f32x4 c1 = *(const LAS f32x4*)(cumL + kb0 + 32 + (q4 & 1) * 4 + (q4 >> 1) * 16);
#pragma unroll
            for (int j = 0; j < 4; ++j) { const int r = q4 * 4 + j; S0[r] = fmaf(S0[r], C2, c0[j]); S1[r] = fmaf(S1[r], C2, c1[j]); }
        }
        if (k0 + 63 > qw_lo) {
            const int dq = qrow - kb0;
#pragma unroll
            for (int r = 0; r < 16; ++r) { const int ko = (r & 7) + 16 * (r >> 3); if (ko > dq) S0[r] = -__builtin_inff(); if (ko + 32 > dq) S1[r] = -__builtin_inff(); }
        }
        float mx = S0[0];
#pragma unroll
        for (int r = 1; r < 16; ++r) mx = fmaxf(mx, S0[r]);
#pragma unroll
        for (int r = 0; r < 16; ++r) mx = fmaxf(mx, S1[r]);
        mx = fmaxf(mx, __shfl_xor(mx, 32));
        const float mnew = fmaxf(mrun, mx), alpha = __builtin_amdgcn_exp2f(mrun - mnew); mrun = mnew;
        float ps = 0.f;
#pragma unroll
        for (int r = 0; r < 16; ++r) { S0[r] = __builtin_amdgcn_exp2f(S0[r] - mnew); S1[r] = __builtin_amdgcn_exp2f(S1[r] - mnew); ps += S0[r] + S1[r]; }
        lrun = lrun * alpha + ps;
#pragma unroll
        for (int i = 0; i < 4; ++i) O[i] *= alpha;
#pragma unroll
        for (int j = 0; j < 2; ++j)
#pragma unroll
            for (int e = 0; e < 4; ++e) { Pk[j][e] = cvtpk(S0[8 * j + 2 * e], S0[8 * j + 2 * e + 1]); Pk[2 + j][e] = cvtpk(S1[8 * j + 2 * e], S1[8 * j + 2 * e + 1]); }
    };
    auto pv = [&](LAS unsigned char* vb) {
#pragma unroll
        for (int sub = 0; sub < 2; ++sub)
#pragma unroll
            for (int j = 0; j < 2; ++j) {
                const bf16x8 Pf = *reinterpret_cast<const bf16x8*>(&Pk[sub * 2 + j]);
#pragma unroll
                for (int db = 0; db < 4; ++db) {
                    const bf16x8 vf = *(const LAS bf16x8*)(vb + (32 * db + c32) * 144 + (32 * sub + 16 * j + 8 * hi) * 2);
                    O[db] = __builtin_amdgcn_mfma_f32_32x32x16_bf16(vf, Pf, O[db], 0, 0, 0);
                }
            }
    };
    const bool late = wid >= 4; bool pvalid = false;
    for (int kt = 0; kt < ntile; ++kt) {
        if (kt + 1 < ntile) gload(kt + 1);
        const bool rel = kt * 64 <= qw_lo + 31;
        if (late && pvalid) pv(vbuf(kt - 1));
        if (rel) qk_sm(kt);
        if (!late && rel) pv(vbuf(kt));
        pvalid = rel;
        if (kt + 1 < ntile) lstore(kt + 1);
        __syncthreads();
    }
    if (late && pvalid) pv(vbuf(ntile - 1));
    { const float lt = lrun + __shfl_xor(lrun, 32), inv = 1.f / lt;
      const size_t grow = (size_t)(bl * SEQ + qrow);
      const u16* zp = p.proj + grow * NP + C_DZ + h * 128; u16* yp = p.ybuf + ((size_t)3 * MG + grow) * 512 + h * 128;
#pragma unroll
      for (int db = 0; db < 4; ++db)
#pragma unroll
          for (int r4 = 0; r4 < 4; ++r4) {
              const int d0 = 32 * db + 8 * r4 + 4 * hi; const u32x2 z = *(const u32x2*)(zp + d0);
              const float o0 = O[db][4 * r4] * inv * siluf_(bflo(z[0])), o1 = O[db][4 * r4 + 1] * inv * siluf_(bfhi(z[0])),
                          o2 = O[db][4 * r4 + 2] * inv * siluf_(bflo(z[1])), o3 = O[db][4 * r4 + 3] * inv * siluf_(bfhi(z[1]));
              u32x2 o = {cvtpk(o0, o1), cvtpk(o2, o3)}; *(u32x2*)(yp + d0) = o; } }
    __syncthreads();
}

constexpr int B_OLAT = 131072;
__device__ __forceinline__ unsigned sortable(float f) { const unsigned b = __float_as_uint(f); return (b & 0x80000000u) ? ~b : (b | 0x80000000u); }
__device__ __forceinline__ void item_dsa(const Params& p, int bl, int rq, LAS unsigned char* lds, int sm = 63) {
    const int tid = opq(threadIdx.x), wid = __builtin_amdgcn_readfirstlane(tid >> 6), lane = tid & 63;
    const int t0 = rq * 8, nmax = t0 + 8, ntile32 = (nmax + 31) >> 5;
    const u16* prow = p.proj + (size_t)bl * SEQ * NP;
    LAS float* sc = (LAS float*)lds;
    { const int c32 = lane & 31, hi = lane >> 5;
      bf16x8 qa[4];
      { const u16* qp = prow + (size_t)(t0 + (c32 >> 2)) * NP + C_QI + (c32 & 3) * 64 + 8 * hi;
#pragma unroll
        for (int ks = 0; ks < 4; ++ks) qa[ks] = *(const bf16x8*)(qp + ks * 16); }
      float wv[16];
#pragma unroll
      for (int r = 0; r < 16; ++r) wv[r] = 0.5f * bf2f(prow[(size_t)(t0 + 2 * (r >> 2) + hi) * NP + C_WI + (r & 3)]);
#pragma unroll
      for (int r = 0; r < 16; ++r) wv[r] *= 0.125f;
      auto ldb = [&](bf16x8 (&kk)[4][4], int i0) {
#pragma unroll
          for (int j = 0; j < 4; ++j) { int T = wid + 8 * (i0 + j); T = T < ntile32 ? T : ntile32 - 1; const u16* kp = p.kiP + (((size_t)bl * 128 + T) * 256 + lane) * 8;
#pragma unroll
              for (int ks = 0; ks < 4; ++ks) kk[j][ks] = *(const bf16x8*)(kp + ks * 512); } };
      auto comp = [&](const bf16x8 (&kk)[4][4], int i0) {
#pragma unroll
          for (int j = 0; j < 4; ++j) {
              const int T = wid + 8 * (i0 + j);
              if (T < ntile32) {
                  const int key = T * 32 + c32;
                  f32x16 a;
#pragma unroll
                  for (int r = 0; r < 16; ++r) a[r] = 0.f;
#pragma unroll
                  for (int ks = 0; ks < 4; ++ks) a = __builtin_amdgcn_mfma_f32_32x32x16_bf16(qa[ks], kk[j][ks], a, 0, 0, 0);
#pragma unroll
                  for (int g4 = 0; g4 < 4; ++g4) { float s = 0.f;
#pragma unroll
                      for (int hh = 0; hh < 4; ++hh) s = fmaf(wv[4 * g4 + hh], fmaxf(a[4 * g4 + hh], 0.f), s);
                      sc[(2 * g4 + hi) * 4096 + key] = s; }
              }
          } };
      if (sm & 1) {
          const int nT = (ntile32 - wid + 7) >> 3;
          bf16x8 ka[4][4], kc[4][4];
          ldb(ka, 0);
          for (int i0 = 0; i0 < nT; i0 += 8) { ldb(kc, i0 + 4); comp(ka, i0); ldb(ka, i0 + 8); comp(kc, i0 + 4); }
      } }
    __syncthreads();
    const int pos = t0 + wid, n = pos + 1, kcount = n < 256 ? n : 256;
    const size_t qgrow = (size_t)pos;
    LAS unsigned char* wbase = lds + wid * 16384;
    LAS unsigned char* aux = lds + B_OLAT + wid * 2048;
    LAS u16* list = (LAS u16*)aux; LAS float* pbuf = (LAS float*)(aux + 1024); LAS float* alf = (LAS float*)(aux + 640);
    { unsigned u[64];
      LAS float* srow = sc + wid * 4096;
#pragma unroll
      for (int r = 0; r < 64; ++r) { u[r] = 0u; if (r * 64 < n) { const float f = srow[r * 64 + lane]; u[r] = (r * 64 + lane < n) ? sortable(f) : 0u; } }
      const int nreg = (n + 63) >> 6;
      unsigned T = 1u; int need = 0, E = 0;
#define CNT_GE(dst, thr) do { _Pragma("unroll") for (int rb = 0; rb < 8; ++rb) { if (rb * 8 < nreg) { \
          unsigned long long m0_, m1_, m2_, m3_, m4_, m5_, m6_, m7_; \
          asm("v_cmp_ge_u32_e64 %0, %8, %16\n\tv_cmp_ge_u32_e64 %1, %9, %16\n\tv_cmp_ge_u32_e64 %2, %10, %16\n\tv_cmp_ge_u32_e64 %3, %11, %16\n\t" \
              "v_cmp_ge_u32_e64 %4, %12, %16\n\tv_cmp_ge_u32_e64 %5, %13, %16\n\tv_cmp_ge_u32_e64 %6, %14, %16\n\tv_cmp_ge_u32_e64 %7, %15, %16" \
              : "=&s"(m0_), "=&s"(m1_), "=&s"(m2_), "=&s"(m3_), "=&s"(m4_), "=&s"(m5_), "=&s"(m6_), "=&s"(m7_) \
              : "v"(u[rb * 8]), "v"(u[rb * 8 + 1]), "v"(u[rb * 8 + 2]), "v"(u[rb * 8 + 3]), "v"(u[rb * 8 + 4]), "v"(u[rb * 8 + 5]), "v"(u[rb * 8 + 6]), "v"(u[rb * 8 + 7]), "s"(thr)); \
          dst += __builtin_popcountll(m0_) + __builtin_popcountll(m1_) + __builtin_popcountll(m2_) + __builtin_popcountll(m3_) \
               + __builtin_popcountll(m4_) + __builtin_popcountll(m5_) + __builtin_popcountll(m6_) + __builtin_popcountll(m7_); } } } while (0)
      if (n > 256 && (sm & 2)) {
          unsigned kp[32]; unsigned basek = 0u; const unsigned ones2 = 0x00010001u;
#pragma unroll
          for (int r2 = 0; r2 < 32; ++r2) { kp[r2] = (u[2 * r2] >> 17) | ((u[2 * r2 + 1] >> 1) & 0x7fff0000u);
              asm("v_dot2_u32_u16 %0, %1, %2, %0" : "+v"(basek) : "v"(kp[r2]), "v"(ones2)); }
          const int nblk = (nreg + 7) >> 3;
          unsigned T15 = 0u; bool exact = false; int cntT = n;
          for (int bit = 14; bit >= 0; --bit) {
              const unsigned c = T15 | (1u << bit), cpk = (c - 1u) * 0x00010001u; unsigned acc = 0u;
#pragma unroll
              for (int rb = 0; rb < 8; ++rb) { if (rb < nblk) {
#pragma unroll
                  for (int r2 = rb * 4; r2 < rb * 4 + 4; ++r2) { unsigned d; asm("v_pk_sub_u16 %0, %1, %2" : "=v"(d) : "v"(cpk), "v"(kp[r2]));
                      asm("v_dot2_u32_u16 %0, %1, %2, %0" : "+v"(acc) : "v"(d), "v"(ones2)); } } }
              const unsigned cl = (acc - (unsigned)(8 * nblk) * (c - 1u) + basek) >> 16;
              int cnt = 0;
#pragma unroll
              for (int b_ = 0; b_ < 7; ++b_) cnt += __builtin_popcountll(__ballot((cl >> b_) & 1u)) << b_;
              if (cnt >= 256) { T15 = c; cntT = cnt; }
              if (cnt == 256) { exact = true; break; }
          }
          T = T15 << 17;
          if (!exact) for (int bit = 16; bit >= 0; --bit) {
              const unsigned cand = T | (1u << bit); int cnt = 0;
              CNT_GE(cnt, cand);
              if (cnt >= 256) { T = cand; cntT = cnt; }
              if (cnt == 256) break;
          }
          if (cntT == 256) { need = 1; E = 1; }
          else { int cgt = 0; const unsigned T1 = T + 1u;
              CNT_GE(cgt, T1); need = 256 - cgt; E = cntT - cgt; }
      }
      if (sm & 4) {
        if (E == need) {
          int c = 0;
#pragma unroll
          for (int rb = 0; rb < 8; ++rb) { if (rb * 8 < nreg) {
#pragma unroll
              for (int r = rb * 8; r < rb * 8 + 8; ++r) c += (u[r] >= T) ? 1 : 0; } }
          int incl = c;
#pragma unroll
          for (int o = 1; o < 64; o <<= 1) { const int y = __shfl_up(incl, o); if (lane >= o) incl += y; }
          int off = incl - c;
#pragma unroll
          for (int rb = 0; rb < 8; ++rb) { if (rb * 8 < nreg) {
#pragma unroll
              for (int r = rb * 8; r < rb * 8 + 8; ++r) { const bool sel = u[r] >= T; list[sel ? off : 256 + lane] = (u16)(r * 64 + lane); off += sel ? 1 : 0; } } }
        } else {
          int outp = 0, tie = 0;
#pragma unroll
          for (int r = 0; r < 64; ++r) {
              if (r * 64 < n) {
                  const bool gt = u[r] > T, eq = (u[r] == T);
                  const unsigned long long meq = __ballot(eq);
                  const int rank = tie + __builtin_amdgcn_mbcnt_hi((unsigned)(meq >> 32), __builtin_amdgcn_mbcnt_lo((unsigned)meq, 0));
                  const bool s = gt || (eq && rank < need);
                  const unsigned long long ms = __ballot(s);
                  const int slot = outp + __builtin_amdgcn_mbcnt_hi((unsigned)(ms >> 32), __builtin_amdgcn_mbcnt_lo((unsigned)ms, 0));
                  if (s) list[slot] = (u16)(r * 64 + lane);
                  outp += __builtin_popcountll(ms); tie += __builtin_popcountll(meq);
              }
          }
        }
      }
#undef CNT_GE
#pragma unroll
      for (int i = 0; i < 4; ++i) { const int slot = i * 64 + lane; if (slot >= kcount) list[slot] = 0; }
    }
    { const int c16 = lane & 15, quad = lane >> 4;
      typedef unsigned short u16x4 __attribute__((ext_vector_type(4)));
      bf16x8 qa[4];
      { const u16* qp = prow + qgrow * NP + C_QL + (c16 & 3) * 128 + quad * 8;
#pragma unroll
        for (int ks = 0; ks < 4; ++ks) qa[ks] = *(const bf16x8*)(qp + ks * 32); }
      f32x4 oacc[8];
#pragma unroll
      for (int c = 0; c < 8; ++c) oacc[c] = (f32x4){0.f, 0.f, 0.f, 0.f};
      const unsigned fsw = ((c16 & 3) << 2) | (c16 >> 2);
      const unsigned wb = (unsigned)(unsigned long long)wbase;
      unsigned tra[8][2];
      { const unsigned q4 = c16 >> 2, p4 = c16 & 3;
#pragma unroll
        for (int t = 0; t < 2; ++t) { const unsigned fv = (q4 << 2) | ((2 * quad + t) & 3), rowb = wb + (8 * quad + 4 * t + q4) * 256 + 8 * (p4 & 1);
#pragma unroll
            for (int c = 0; c < 8; ++c) tra[c][t] = rowb + 16 * ((2 * c + (p4 >> 1)) ^ fv); } }
      LAS u16* pbT = (LAS u16*)pbuf;
      float mrun = -1e30f, lsum = 0.f;
      const int nb = (sm & 8) ? ((kcount + 63) >> 6) : 0;
      u32x4 w[4][4];
      auto gl = [&](int b) {
#pragma unroll
          for (int jj = 0; jj < 4; ++jj) { const int kx = list[(b * 4 + jj) * 16 + c16] & 4095; const u16* cp = prow + (size_t)kx * NP + C_BC + quad * 8;
#pragma unroll
              for (int ks = 0; ks < 4; ++ks) w[jj][ks] = *(const u32x4*)(cp + ks * 32); } };
      if (nb > 0) gl(0);
      for (int b = 0; b < nb; ++b) {
          float lgv[4], rsv[4];
#pragma unroll
          for (int jj = 0; jj < 4; ++jj) {
              const int rho = jj * 16 + c16, slot = b * 64 + rho;
              f32x4 a = {0.f, 0.f, 0.f, 0.f}; float ss = 0.f;
#pragma unroll
              for (int ks = 0; ks < 4; ++ks) {
#pragma unroll
                  for (int e = 0; e < 4; ++e) asm("v_dot2_f32_bf16 %0, %1, %1, %0" : "+v"(ss) : "v"(w[jj][ks][e]));
                  a = __builtin_amdgcn_mfma_f32_16x16x32_bf16(qa[ks], *reinterpret_cast<const bf16x8*>(&w[jj][ks]), a, 0, 0, 0);
                  *(LAS u32x4*)(wbase + rho * 256 + (((ks * 4 + quad) ^ fsw) << 4)) = w[jj][ks]; }
              ss += __shfl_xor(ss, 16); ss += __shfl_xor(ss, 32);
              const float rstd = rsqrtf(ss * (1.f / 128.f) + EPS);
              const float av = quad == 0 ? a[0] : (quad == 1 ? a[1] : (quad == 2 ? a[2] : a[3]));
              rsv[jj] = rstd; lgv[jj] = (slot < kcount) ? av * rstd * 0.08838834764831845f : -__builtin_inff();
          }
          if (b + 1 < nb) gl(b + 1);
          float mx = fmaxf(fmaxf(lgv[0], lgv[1]), fmaxf(lgv[2], lgv[3]));
#pragma unroll
          for (int o = 1; o < 16; o <<= 1) mx = fmaxf(mx, __shfl_xor(mx, o));
          const float mnew = fmaxf(mrun, mx), alpha = __expf(mrun - mnew); mrun = mnew;
          float ps = 0.f;
#pragma unroll
          for (int jj = 0; jj < 4; ++jj) { const float pe = __expf(lgv[jj] - mnew); ps += pe; pbT[quad * 64 + jj * 16 + c16] = f2bf(pe * rsv[jj]); }
          lsum = lsum * alpha + ps;
          if (c16 == 0) alf[quad] = alpha;
          const f32x4 al4 = *(const LAS f32x4*)alf;
#pragma unroll
          for (int c = 0; c < 8; ++c) oacc[c] *= al4;
#pragma unroll
          for (int ks = 0; ks < 2; ++ks) {
              const bf16x8 pf = *(const LAS bf16x8*)(pbT + (c16 & 3) * 64 + ks * 32 + quad * 8);
              u16x4 t0[8], t1[8];
#define TRR8(dst, tt, OFF) asm volatile("ds_read_b64_tr_b16 %0, %8 offset:" #OFF "\n\tds_read_b64_tr_b16 %1, %9 offset:" #OFF "\n\tds_read_b64_tr_b16 %2, %10 offset:" #OFF "\n\tds_read_b64_tr_b16 %3, %11 offset:" #OFF "\n\t" \
                  "ds_read_b64_tr_b16 %4, %12 offset:" #OFF "\n\tds_read_b64_tr_b16 %5, %13 offset:" #OFF "\n\tds_read_b64_tr_b16 %6, %14 offset:" #OFF "\n\tds_read_b64_tr_b16 %7, %15 offset:" #OFF "\n\ts_waitcnt lgkmcnt(0)" \
                  : "=&v"(dst[0]), "=&v"(dst[1]), "=&v"(dst[2]), "=&v"(dst[3]), "=&v"(dst[4]), "=&v"(dst[5]), "=&v"(dst[6]), "=&v"(dst[7]) \
                  : "v"(tra[0][tt]), "v"(tra[1][tt]), "v"(tra[2][tt]), "v"(tra[3][tt]), "v"(tra[4][tt]), "v"(tra[5][tt]), "v"(tra[6][tt]), "v"(tra[7][tt]) : "memory")
              if (ks == 0) { TRR8(t0, 0, 0); TRR8(t1, 1, 0); } else { TRR8(t0, 0, 8192); TRR8(t1, 1, 8192); }
#undef TRR8
#pragma unroll
              for (int c = 0; c < 8; ++c) {
                  const bf16x8 bf = {(short)t0[c][0], (short)t0[c][1], (short)t0[c][2], (short)t0[c][3], (short)t1[c][0], (short)t1[c][1], (short)t1[c][2], (short)t1[c][3]};
                  oacc[c] = __builtin_amdgcn_mfma_f32_16x16x32_bf16(pf, bf, oacc[c], 0, 0, 0);
              }
          }
      }
#pragma unroll
      for (int o = 1; o < 16; o <<= 1) lsum += __shfl_xor(lsum, o);
      if (c16 == 0) alf[quad] = 1.f / lsum;
      const f32x4 il4 = *(const LAS f32x4*)alf;
      LAS u16* olat = (LAS u16*)wbase;
#pragma unroll
      for (int c = 0; c < 8; ++c) {
          if ((c >> 1) == quad) {
#pragma unroll
              for (int hh = 0; hh < 4; ++hh) olat[hh * 128 + c * 16 + c16] = f2bf(oacc[c][hh] * il4[hh]);
          }
      }
    }
    { const int c16 = lane & 15, quad = lane >> 4, hh = wid >> 1;
      bf16x8 wf[4][4]; u16 zv[4][4];
#pragma unroll
      for (int i = 0; i < 4; ++i) { const int d = ((wid & 1) * 4 + i) * 16 + c16; const u16* wp = p.WuvT + ((size_t)hh * 128 + d) * 128 + quad * 8;
#pragma unroll
          for (int ks = 0; ks < 4; ++ks) wf[i][ks] = *(const bf16x8*)(wp + ks * 32);
#pragma unroll
          for (int j = 0; j < 4; ++j) zv[i][j] = p.proj[(size_t)(bl * SEQ + t0 + 4 * (quad & 1) + j) * NP + C_BZ + hh * 128 + d]; }
      __syncthreads();
      if (sm & 32) {
          LAS u16* olat = (LAS u16*)(lds + (c16 & 7) * 16384);
          bf16x8 af[4];
#pragma unroll
          for (int ks = 0; ks < 4; ++ks) af[ks] = *(const LAS bf16x8*)(olat + hh * 128 + ks * 32 + quad * 8);
#pragma unroll
          for (int i = 0; i < 4; ++i) {
              const int d = ((wid & 1) * 4 + i) * 16 + c16;
              f32x4 a = {0.f, 0.f, 0.f, 0.f};
#pragma unroll
              for (int ks = 0; ks < 4; ++ks) a = __builtin_amdgcn_mfma_f32_16x16x32_bf16(af[ks], wf[i][ks], a, 0, 0, 0);
              if (quad < 2 && sm == 63) {
#pragma unroll
                  for (int j = 0; j < 4; ++j) { const size_t grow = (size_t)(bl * SEQ + t0 + 4 * quad + j);
                      p.ybuf[((size_t)1 * MG + grow) * 512 + hh * 128 + d] = f2bf(a[j] * siluf_(bf2f(zv[i][j]))); }
              }
          }
      }
    }
    __syncthreads();
}

__device__ __forceinline__ void item_gate(const Params& p, int l, int bl, int ch, LAS unsigned char* lds) {
    const int tid = opq(threadIdx.x); const size_t r0 = (size_t)bl * SEQ + ch * 128;
    LAS float* stats = (LAS float*)lds;
    { const int tok = tid >> 2, part = tid & 3; const u16* vp = p.proj + (r0 + tok) * NP + C_AV + part * 128;
      u32x4 w[16]; float s = 0.f;
#pragma unroll
      for (int i = 0; i < 16; ++i) { w[i] = *(const u32x4*)(vp + i * 8);
#pragma unroll
          for (int e = 0; e < 4; ++e) s += bflo(w[i][e]) + bfhi(w[i][e]); }
      s += __shfl_xor(s, 1); s += __shfl_xor(s, 2); const float mean = s * (1.f / 512.f);
      float q = 0.f;
#pragma unroll
      for (int i = 0; i < 16; ++i)
#pragma unroll
          for (int e = 0; e < 4; ++e) { const float a = bflo(w[i][e]) - mean, b = bfhi(w[i][e]) - mean; q = fmaf(a, a, q); q = fmaf(b, b, q); }
      q += __shfl_xor(q, 1); q += __shfl_xor(q, 2);
      if (part == 0) { stats[tok * 2] = mean; stats[tok * 2 + 1] = rsqrtf(q * (1.f / 512.f) + EPS); } }
    __syncthreads();
    { const int chn = tid; const float lg = p.gm_ln_g[l * 512 + chn], lb = p.gm_ln_b[l * 512 + chn]; const u16* vp = p.proj + r0 * NP + C_AV + chn;
      LAS unsigned char* vrow = lds + 4096 + chn * 272;
#pragma unroll 4
      for (int s8 = 0; s8 < 16; ++s8) { float v[8];
#pragma unroll
          for (int e = 0; e < 8; ++e) { const int ss = s8 * 8 + e; v[e] = (bf2f(vp[(size_t)ss * NP]) - stats[ss * 2]) * stats[ss * 2 + 1] * lg + lb; }
          u32x4 o = {cvtpk(v[0], v[1]), cvtpk(v[2], v[3]), cvtpk(v[4], v[5]), cvtpk(v[6], v[7])};
          *(LAS u32x4*)(vrow + s8 * 16) = o; } }
    __syncthreads();
    { const int wid = __builtin_amdgcn_readfirstlane(tid >> 6), lane = tid & 63, c32 = lane & 31, hi = lane >> 5, g = wid >> 1, cb2 = wid & 1;
      const float* wsb = p.gm_w_s + ((size_t)(l * 4 + g)) * 128 * 128; const float* bsb = p.gm_b_s + (l * 4 + g) * 128;
      const int ch0 = g * 128 + cb2 * 64 + c32;
      for (int tb = 0; tb < 4; ++tb) {
          f32x16 a0, a1;
#pragma unroll
          for (int r = 0; r < 16; ++r) { a0[r] = 0.f; a1[r] = 0.f; }
          const int trow = tb * 32 + c32;
          for (int sb = 0; sb <= tb; ++sb) {
#pragma unroll
              for (int ks = 0; ks < 2; ++ks) {
                  const int sc0 = sb * 32 + ks * 16 + hi * 8;
                  const f32x4 w0 = *(const f32x4*)(wsb + trow * 128 + sc0), w1 = *(const f32x4*)(wsb + trow * 128 + sc0 + 4);
                  float wv[8] = {w0[0], w0[1], w0[2], w0[3], w1[0], w1[1], w1[2], w1[3]};
#pragma unroll
                  for (int e = 0; e < 8; ++e) if (sc0 + e > trow) wv[e] = 0.f;
                  u32x4 aw = {cvtpk(wv[0], wv[1]), cvtpk(wv[2], wv[3]), cvtpk(wv[4], wv[5]), cvtpk(wv[6], wv[7])};
                  const bf16x8 af = *reinterpret_cast<bf16x8*>(&aw);
                  const bf16x8 b0 = *(const LAS bf16x8*)(lds + 4096 + ch0 * 272 + sc0 * 2);
                  const bf16x8 b1 = *(const LAS bf16x8*)(lds + 4096 + (ch0 + 32) * 272 + sc0 * 2);
                  a0 = __builtin_amdgcn_mfma_f32_32x32x16_bf16(af, b0, a0, 0, 0, 0);
                  a1 = __builtin_amdgcn_mfma_f32_32x32x16_bf16(af, b1, a1, 0, 0, 0);
              }
          }
#pragma unroll
          for (int r = 0; r < 16; ++r) {
              const int t = tb * 32 + (r & 3) + 8 * (r >> 2) + 4 * hi; const float bs = bsb[t];
              const u16* pr = p.proj + (r0 + t) * NP; u16* yr = p.ybuf + ((size_t)0 * MG + r0 + t) * 512;
              { const float uu = bf2f(pr[C_AU + ch0]), zz = bf2f(pr[C_AZ + ch0]); yr[ch0] = f2bf(uu * (a0[r] + bs) * siluf_(zz)); }
              { const float uu = bf2f(pr[C_AU + ch0 + 32]), zz = bf2f(pr[C_AZ + ch0 + 32]); yr[ch0 + 32] = f2bf(uu * (a1[r] + bs) * siluf_(zz)); }
          }
      }
    }
    __syncthreads();
}
__device__ __forceinline__ void item_conv(const Params& p, int l, int it) {
    const int tid = opq(threadIdx.x), cc = tid & 63, tb = tid >> 6; const int r0 = it * 128 + tb * 16, s0 = r0 & 4095;
    float w0[8], w1[8], w2[8];
#pragma unroll
    for (int e = 0; e < 8; ++e) { w0[e] = p.conv_w[(l * 3 + 0) * 512 + cc * 8 + e]; w1[e] = p.conv_w[(l * 3 + 1) * 512 + cc * 8 + e]; w2[e] = p.conv_w[(l * 3 + 2) * 512 + cc * 8 + e]; }
    float y2[8], y1[8];
    auto ld8 = [&](int r, int col, float* o) { const u32x4 w = *(const u32x4*)(p.proj + (size_t)r * NP + col + cc * 8);
#pragma unroll
        for (int e = 0; e < 4; ++e) { o[2 * e] = bflo(w[e]); o[2 * e + 1] = bfhi(w[e]); } };
    auto ycx = [&](int r, float* o) { float a[8], b[8]; ld8(r, C_CC, a); ld8(r, C_CX, b);
#pragma unroll
        for (int e = 0; e < 8; ++e) o[e] = a[e] * b[e]; };
#pragma unroll
    for (int e = 0; e < 8; ++e) { y2[e] = 0.f; y1[e] = 0.f; }
    if (s0 >= 2) ycx(r0 - 2, y2);
    if (s0 >= 1) ycx(r0 - 1, y1);
    for (int i = 0; i < 16; ++i) {
        const int r = r0 + i; float y0[8], bb[8], zz[8], o[8]; ycx(r, y0); ld8(r, C_CB, bb); ld8(r, C_CZ, zz);
#pragma unroll
        for (int e = 0; e < 8; ++e) { o[e] = bb[e] * (w0[e] * y2[e] + w1[e] * y1[e] + w2[e] * y0[e]) * siluf_(zz[e]); y2[e] = y1[e]; y1[e] = y0[e]; }
        u32x4 ow = {cvtpk(o[0], o[1]), cvtpk(o[2], o[3]), cvtpk(o[4], o[5]), cvtpk(o[6], o[7])};
        *(u32x4*)(p.ybuf + ((size_t)2 * MG + r) * 512 + cc * 8) = ow;
    }
}
__device__ __forceinline__ void step_mix(const Params& p, int l, unsigned* ctr, LAS unsigned char* lds, int tmask = 15, int smask = 63) {
    LAS int* sitem = (LAS int*)(lds + ITEM_OFF);
    constexpr int N_D = 256, N_B = 2048, N_A = 128, N_C = 128, N_ALL = N_D + N_B + N_A + N_C;
    const int pref = (((blockIdx.x >> 3) & 3u) != 0u) ? 1 : 0;
    auto fetch = [&]() -> int {
        if (pref == 0) { int i = (int)atomicAdd(ctr, 1u); if (i < N_D) return i; i = (int)atomicAdd(ctr + 32, 1u); return i < N_ALL - N_D ? N_D + i : N_ALL; }
        int i = (int)atomicAdd(ctr + 32, 1u); if (i < N_ALL - N_D) return N_D + i; i = (int)atomicAdd(ctr, 1u); return i < N_D ? i : N_ALL; };
    int nxt = 0;
    if (threadIdx.x == 0) nxt = fetch();
    for (;;) {
        __syncthreads();
        if (threadIdx.x == 0) *sitem = nxt;
        __syncthreads();
        const int it = __builtin_amdgcn_readfirstlane(*sitem);
        if (threadIdx.x == 0 && it < N_ALL) nxt = fetch();
        if (it >= N_ALL) break;
        if (it < N_D) { if (!(tmask & 1)) continue; const int qb = 15 - (it >> 4), bh = it & 15; item_fox(p, l, bh >> 2, bh & 3, qb, lds); }
        else if (it < N_D + N_B) { if (!(tmask & 2)) continue; const int j = it - N_D; const int rq = 511 - (j >> 2), bl = j & 3; item_dsa(p, bl, rq, lds, smask); }
        else if (it < N_D + N_B + N_A) { if (!(tmask & 4)) continue; const int j = it - N_D - N_B; item_gate(p, l, j >> 5, j & 31, lds); }
        else { if (!(tmask & 8)) continue; item_conv(p, l, it - N_D - N_B - N_A); }
    }
}


#define XB_TMO      128
#define XB_XCNT(j)  (256  + 64 * (j))
#define XB_XSUB(j)  (1280 + 64 * (j))
#define XB_XGEN(j)  (2304 + 64 * (j))
#define XB_TOP      3328
#define XB_TOPGEN   3392
#define XCD_BAR_WORDS 3456
#define XB_SPIN_CAP (1u << 22)
__device__ __forceinline__ unsigned xb_ld(unsigned* p)              { return __hip_atomic_load(p, __ATOMIC_RELAXED, __HIP_MEMORY_SCOPE_AGENT); }
__device__ __forceinline__ unsigned xb_add(unsigned* p, unsigned v) { return __hip_atomic_fetch_add(p, v, __ATOMIC_RELAXED, __HIP_MEMORY_SCOPE_AGENT); }
__device__ __forceinline__ unsigned xb_xcc_id() { return (unsigned)__builtin_amdgcn_s_getreg((3 << 11) | 20) & 0xFu; }
#define XB_SPIN(cond, bar) do { unsigned _sp = 0; while (cond) { __builtin_amdgcn_s_sleep(1); \
    if ((++_sp & 255u) == 0u) { if (xb_ld(&(bar)[XB_TMO])) break; if (_sp > XB_SPIN_CAP) { atomicAdd(&(bar)[XB_TMO], 1u); break; } } } } while (0)
struct XcdBarrier { unsigned* bar; unsigned x; volatile LAS unsigned* st; };
__device__ __forceinline__ XcdBarrier xcd_barrier_post(unsigned* bar, volatile LAS unsigned* st) {
    XcdBarrier b; b.bar = bar; b.x = xb_xcc_id(); b.st = st;
    if (threadIdx.x == 0) (void)xb_add(&bar[XB_XCNT(b.x)], 1u);
    return b;
}
__device__ __forceinline__ void xcd_barrier_complete(unsigned* bar, unsigned x, unsigned& nloc, unsigned& nx) {
    const unsigned G = gridDim.x * gridDim.y * gridDim.z;
    unsigned sum, cnt, mine, sp = 0u;
    for (;;) {
        sum = 0u; cnt = 0u; mine = 0u;
#pragma unroll
        for (unsigned j = 0; j < 16; ++j) { const unsigned c = xb_ld(&bar[XB_XCNT(j)]); sum += c; cnt += (c > 0u) ? 1u : 0u; mine = (j == x) ? c : mine; }
        if (sum == G) break;
        __builtin_amdgcn_s_sleep(1);
        if ((++sp & 255u) == 0u) { if (xb_ld(&bar[XB_TMO])) break; if (sp > XB_SPIN_CAP) { atomicAdd(&bar[XB_TMO], 1u); break; } }
    }
    nloc = mine > 0u ? mine : 1u; nx = cnt > 0u ? cnt : 1u;
}
__device__ __forceinline__ void xcd_barrier(const XcdBarrier& b) {
    asm volatile("s_waitcnt vmcnt(0)" ::: "memory");
    __syncthreads();
    if (threadIdx.x == 0) {
        unsigned* bar = b.bar;
        __builtin_amdgcn_s_waitcnt(0);
        unsigned nloc = b.st[0], nx = b.st[1];
        if (nloc == 0u) { xcd_barrier_complete(bar, b.x, nloc, nx); b.st[0] = nloc; b.st[1] = nx; }
        const unsigned old = xb_add(&bar[XB_XSUB(b.x)], 1u);
        const unsigned gen = old / nloc;
        if (old + 1u == (gen + 1u) * nloc) {
            __builtin_amdgcn_fence(__ATOMIC_RELEASE, "agent");
            asm volatile("s_waitcnt vmcnt(0)" ::: "memory");
            const unsigned og = xb_add(&bar[XB_TOP], 1u);
            const unsigned tg = og / nx;
            if (og + 1u == (tg + 1u) * nx) xb_add(&bar[XB_TOPGEN], 1u);
            else XB_SPIN(xb_ld(&bar[XB_TOPGEN]) == tg, bar);
            __builtin_amdgcn_fence(__ATOMIC_ACQUIRE, "agent");
            xb_add(&bar[XB_XGEN(b.x)], 1u);
            asm volatile("s_waitcnt vmcnt(0)" ::: "memory");
        } else {
            XB_SPIN(xb_ld(&bar[XB_XGEN(b.x)]) == gen, bar);
            __builtin_amdgcn_fence(__ATOMIC_ACQUIRE, "agent");
            asm volatile("s_waitcnt vmcnt(0)" ::: "memory");
        }
    }
    __syncthreads();
}

#ifndef REPS
#define REPS 63
#endif
#ifndef REPT
#define REPT 15
#endif
#ifndef REPK
#define REPK 0
#endif
__device__ __forceinline__ void run_step(const Params& p, int s, LAS unsigned char* lds, int rep = 0) {
    if (s == NSTEP - 1) { step_final(p); return; }
    const int l = s / (NGRP * NK), g = (s / NK) % NGRP, k = s % NK;
    if (k == 0) { if (g == 0) step_prep(p, l, lds); step_norm(p, l, g); }
    else if (k == 1) { pg8::Gemm gm{p.hbuf, p.Wt, MG, NP, DM, 1 << 20, 0}; pg8::StaticOrder S; S.init(MG, NP, gridDim.x, blockIdx.x); EpiG1 E{p.proj, p.vT, p.kiP, p.gq}; pg8::gemm_phase(lds, gm, S, E); }
    else if (k == 2) { step_mix(p, l, p.ctr + (l * NGRP + g) + 16 * rep, lds, rep ? REPT : 15, rep ? REPS : 63); }
    else if (k == 3) { pg8::Gemm gm{p.ybuf, p.Wb, MG, 4096, 512, 4, (size_t)MG * 512 * 2}; pg8::BranchOrder S{(int)gridDim.x, (int)blockIdx.x, (MG / 256) * 4}; EpiG2 E{p.gq, p.hbuf}; pg8::gemm_phase(lds, gm, S, E); }
    else { pg8::Gemm gm{p.hbuf, p.Wo, MG, DM, DM, 1 << 20, 0}; pg8::StaticOrder S; S.init(MG, DM, gridDim.x, blockIdx.x); EpiG3 E{(l == 0) ? p.x : p.out, rep ? (float*)p.proj - (size_t)g * MG * DM : p.out, g * MG}; pg8::gemm_phase(lds, gm, S, E); }
}
__global__ __launch_bounds__(512, 2) void mega(Params p, int s0, int s1) {
    extern __shared__ __attribute__((aligned(16))) unsigned char shm[];
    LAS unsigned char* lds = (LAS unsigned char*)shm;
    cg::grid_group grid = cg::this_grid();
    volatile LAS unsigned* st = (volatile LAS unsigned*)(lds + XB_ST_OFF);
    if (threadIdx.x == 0) { st[0] = 0u; st[1] = 0u; }
    __syncthreads();
    const XcdBarrier xb = xcd_barrier_post(p.bar, st);
    for (int s = s0; s < s1; ++s) { run_step(p, s, lds);
        if (s + 1 < s1) { if (s1 < 0) grid.sync(); else xcd_barrier(xb); } }
}

extern "C" void kernel_launch(void* const* d_in, const int* in_sizes, int n_in, void* d_out, int out_size, void* d_ws, size_t ws_size, hipStream_t stream) {
    static int grid = 0;
    if (grid == 0) {
        int dev = 0, cus = 0, per_cu = 0;
        hipGetDevice(&dev); hipDeviceGetAttribute(&cus, hipDeviceAttributeMultiprocessorCount, dev);
        hipFuncSetAttribute((const void*)mega, hipFuncAttributeMaxDynamicSharedMemorySize, LDS_BYTES);
        hipOccupancyMaxActiveBlocksPerMultiprocessor(&per_cu, (const void*)mega, 512, LDS_BYTES);
        if (per_cu < 1) per_cu = 1;
        grid = cus * per_cu;
    }
    Params p{};
    const float** f = (const float**)&p;
    for (int i = 0; i < 15; ++i) f[i] = (const float*)d_in[i];
    p.out = (float*)d_out;
    unsigned char* w = (unsigned char*)d_ws; size_t o = 0;
    auto take = [&](size_t bytes) { unsigned char* r = w + o; o += (bytes + 255) & ~(size_t)255; return r; };
    p.ctr = (unsigned*)take(256); p.bar = (unsigned*)take((size_t)XCD_BAR_WORDS * 4);
    p.Wt = (u16*)take((size_t)NP * DM * 2); p.Wb = (u16*)take((size_t)4096 * 512 * 2); p.Wo = (u16*)take((size_t)DM * DM * 2); p.WuvT = (u16*)take((size_t)4 * 128 * 128 * 2);
    p.hbuf = (u16*)take((size_t)MG * DM * 2); p.ybuf = (u16*)take((size_t)4 * MG * 512 * 2); p.vT = (u16*)take((size_t)BG * 4 * 128 * 4096 * 2);
    p.kiP = (u16*)take((size_t)BG * 4096 * 64 * 2);
    p.gq = (unsigned char*)take((size_t)MG * 4096);
    p.proj = (u16*)take((size_t)MG * NP * 2);
    if (o > ws_size) { fprintf(stderr, "workspace too small: need %zu have %zu\n", o, ws_size); return; }
    hipMemsetAsync(p.ctr, 0, 256 + (size_t)XCD_BAR_WORDS * 4, stream);
#if FUSED
    int s0 = 0, s1 = NSTEP; void* args[] = {&p, &s0, &s1};
    hipError_t e = hipLaunchCooperativeKernel((const void*)mega, dim3(grid), dim3(512), args, LDS_BYTES, stream);
    if (e != hipSuccess) fprintf(stderr, "cooperative launch failed: %s (grid %d)\n", hipGetErrorString(e), grid);
#else
    for (int s = 0; s < NSTEP; ++s) hipLaunchKernelGGL(mega, dim3(grid), dim3(512), LDS_BYTES, stream, p, s, s + 1);
#endif
}
```

```cpp
#include <hip/hip_runtime.h>
#include <hip/hip_cooperative_groups.h>
#include <cstdio>
namespace cg = cooperative_groups;

#define LAS __attribute__((address_space(3)))
typedef unsigned short u16;
typedef short bf16x8 __attribute__((ext_vector_type(8)));
typedef float f32x4 __attribute__((ext_vector_type(4)));
typedef float f32x16 __attribute__((ext_vector_type(16)));
typedef unsigned u32x4 __attribute__((ext_vector_type(4)));
typedef unsigned u32x2 __attribute__((ext_vector_type(2)));
typedef float f32x2 __attribute__((ext_vector_type(2)));

#ifndef FUSED
#define FUSED 1
#endif

constexpr int DM = 1024, SEQ = 4096, DEPTH = 4;
constexpr int MG = 16384, BG = 4, NGRP = 2;
constexpr int NP = 11264, INW = 11208;
constexpr int C_AU = 0, C_AV = 512, C_AZ = 1024, C_QL = 1536, C_BC = 2048, C_QI = 2176, C_KI = 2432, C_WI = 2496, C_DF = 2500,
              C_BZ = 2560, C_CB = 3072, C_CC = 3584, C_CX = 4096, C_CZ = 4608, C_DQ = 5120, C_DK = 5632, C_DV = 6144, C_DZ = 6656, C_G = 7168;
constexpr int LDS_BYTES = 147456 + 64, XB_ST_OFF = 147456, ITEM_OFF = 131776;
constexpr int NK = 5;
constexpr int NSTEP = DEPTH * NGRP * NK + 1;
constexpr float EPS = 1e-6f;

struct Params {
    const float *x, *norm_g, *w_in, *gm_ln_g, *gm_ln_b, *gm_w_s, *gm_b_s, *dsa_kv_g, *dsa_w_uk, *dsa_w_uv, *conv_w, *fox_b_f, *w_branch, *w_out, *final_g;
    float* out;
    u16 *Wt, *Wb, *Wo, *WuvT, *hbuf, *proj, *ybuf, *vT, *kiP;
    unsigned* ctr; unsigned* bar; unsigned char* gq;
};

__device__ __forceinline__ float bf2f(u16 b) { return __uint_as_float(((unsigned)b) << 16); }
__device__ __forceinline__ float bflo(unsigned w) { return __uint_as_float(w << 16); }
__device__ __forceinline__ float bfhi(unsigned w) { return __uint_as_float(w & 0xffff0000u); }
__device__ __forceinline__ unsigned cvtpk(float lo, float hi) { unsigned r; asm volatile("v_cvt_pk_bf16_f32 %0, %1, %2" : "=v"(r) : "v"(lo), "v"(hi)); return r; }
__device__ __forceinline__ u16 f2bf(float f) { return (u16)(cvtpk(f, 0.f) & 0xffffu); }
__device__ __forceinline__ float sigmoidf_(float x) { return __builtin_amdgcn_rcpf(1.f + __expf(-x)); }
__device__ __forceinline__ float siluf_(float x) { return x * sigmoidf_(x); }
__device__ __forceinline__ int opq(int x) { asm volatile("" : "+v"(x)); return x; }
__device__ __forceinline__ float wave_sum(float v) { for (int o = 32; o >= 1; o >>= 1) v += __shfl_xor(v, o); return v; }

namespace pg8 {
constexpr int BM = 256, BK = 64, HALF = 128, HTB = HALF * BK * 2, NXCD = 8, WGM = 4;
__device__ __forceinline__ int lds_byte(int r, int c) { const int st = (r >> 4) * 2 + (c >> 5), rr = r & 15, cc = c & 31, ob = rr * 64 + cc * 2; return st * 1024 + (ob ^ (((ob >> 9) & 1) << 5)); }
__device__ __forceinline__ int perm32(int rho) { const int n = rho >> 4, i = rho & 15; return 8 * (i >> 2) + 4 * n + (i & 3); }
__device__ __forceinline__ void stage_rc(int b, int& R, int& C) { const int st = b / 1024, sb = b % 1024, swz = sb ^ (((sb >> 9) & 1) << 5); R = (st >> 1) * 16 + swz / 64; C = (st & 1) * 32 + (swz % 64) / 2; }
struct Unit { int pm, pn; };
struct Gemm { const u16* A; const u16* Bt; int M, N, K; int pn_per_grp; size_t a_grp_bytes; };
struct StaticOrder {
    int nM, nN, nwg, G, c;
    __device__ void init(int M, int N, int G_, int c_) { nM = M / BM; nN = N / BM; nwg = nM * nN; G = G_; c = c_; }
    __device__ bool next(int i, Unit& u) const {
        const long L = (long)i * G + c; if (L >= nwg) return false;
        int wgid = (int)L; { const int q = nwg / NXCD, r = nwg % NXCD, xcd = wgid % NXCD, off = wgid / NXCD; wgid = (xcd < r ? xcd * (q + 1) : r * (q + 1) + (xcd - r) * q) + off; }
        const int nig = WGM * nN, gid = wgid / nig, fm = gid * WGM, gsz = (nM - fm) < WGM ? (nM - fm) : WGM;
        u.pm = fm + ((wgid % nig) % gsz); u.pn = (wgid % nig) / gsz;
        if (nN == 44) u.pn = (u.pn + 5 * (int)(L % NXCD)) % 44;
        return true;
    }
};
struct BranchOrder {
    int G, c, ntile;
    __device__ bool next(int i, Unit& u) const { const int tile = c + (i >> 2) * G; if (tile >= ntile) return false; u.pm = tile >> 2; u.pn = (i & 3) * 4 + (tile & 3); return true; }
};
template <class Epi, class Sched>
__device__ __forceinline__ void gemm_phase(LAS unsigned char* lds, const Gemm g, const Sched& S, const Epi& E) {
    const int tid = opq(threadIdx.x), wid = __builtin_amdgcn_readfirstlane(tid >> 6), lane = tid & 63, wr = wid >> 2, wc = wid & 3, fr = lane & 15, fq = lane >> 4;
    const int K = g.K, nt = K / BK;
    unsigned voffA[2], voffB[2];
#pragma unroll
    for (int i = 0; i < 2; ++i) { int R, C; stage_rc(tid * 16 + i * 8192, R, C); const int Rb = Epi::PERM ? ((R & ~31) + perm32(R & 31)) : R;
        voffA[i] = (unsigned)(R * K + C) * 2u; voffB[i] = (unsigned)(Rb * K + C) * 2u; }
    const size_t kstep = (size_t)(BK * 2);
    const size_t hstep = (size_t)HALF * K * 2;
    const size_t tstep = 2 * hstep;
    const unsigned ldsw = (unsigned)wid * 1024u;
    const int aoff = lds_byte(wr * 64 + fr, fq * 8), boff = lds_byte(wc * 32 + fr, fq * 8);
#define PG8_SA(b, h) (((b) * 2 + (h)) * HTB)
#define PG8_SB(b, h) ((4 + (b) * 2 + (h)) * HTB)
#define PG8_STAGE(bufoff, gbase, voff) do { _Pragma("unroll") for (int _i = 0; _i < 2; ++_i) \
        __builtin_amdgcn_global_load_lds((const unsigned*)((const char*)(gbase) + (voff)[_i]), (LAS unsigned*)(lds + (bufoff) + ldsw + _i * 8192), 16, 0, 0); } while (0)
#define PG8_LDA(dst, b, h) do { _Pragma("unroll") for (int m = 0; m < 4; ++m) _Pragma("unroll") for (int k = 0; k < 2; ++k) dst[m][k] = *(const LAS bf16x8*)(lds + PG8_SA(b, h) + aoff + m * 2048 + k * 1024); } while (0)
#define PG8_LDB(dst, b, h) do { _Pragma("unroll") for (int n = 0; n < 2; ++n) _Pragma("unroll") for (int k = 0; k < 2; ++k) dst[n][k] = *(const LAS bf16x8*)(lds + PG8_SB(b, h) + boff + n * 2048 + k * 1024); } while (0)
#define PG8_MMA(ai, bj, At, Bt) do { __builtin_amdgcn_s_setprio(1); _Pragma("unroll") for (int m = 0; m < 4; ++m) _Pragma("unroll") for (int n = 0; n < 2; ++n) _Pragma("unroll") for (int k = 0; k < 2; ++k) \
        acc[ai][bj][m][n] = __builtin_amdgcn_mfma_f32_16x16x32_bf16(Bt[n][k], At[m][k], acc[ai][bj][m][n], 0, 0, 0); __builtin_amdgcn_s_setprio(0); } while (0)
#define PG8_WAIT_V(n) asm volatile("s_waitcnt vmcnt(" #n ")" ::: "memory")
#define PG8_WAIT_L(n) asm volatile("s_waitcnt lgkmcnt(" #n ")" ::: "memory")
#define PG8_BAR __builtin_amdgcn_s_barrier()
#define PG8_SCHED __builtin_amdgcn_sched_barrier(0)
    Unit cur, nxt; int ui = 0;
    if (!S.next(0, cur)) return;
    f32x4 acc[2][2][4][2];
#pragma unroll
    for (int a = 0; a < 2; ++a)
#pragma unroll
        for (int b = 0; b < 2; ++b)
#pragma unroll
            for (int m = 0; m < 4; ++m)
#pragma unroll
                for (int n = 0; n < 2; ++n) acc[a][b][m][n] = (f32x4){0.f, 0.f, 0.f, 0.f};
    bf16x8 At[4][2], B0[2][2], B1[2][2];
    const char* cA = (const char*)g.A + (size_t)cur.pm * tstep + (size_t)(cur.pn / g.pn_per_grp) * g.a_grp_bytes; const char* cB = (const char*)g.Bt + (size_t)cur.pn * tstep;
    PG8_STAGE(PG8_SB(0, 0), cB, voffB); PG8_STAGE(PG8_SA(0, 0), cA, voffA); PG8_STAGE(PG8_SB(0, 1), cB + hstep, voffB); PG8_STAGE(PG8_SA(0, 1), cA + hstep, voffA);
    if (wr == 1) PG8_BAR;
    PG8_WAIT_V(4); PG8_BAR;
    PG8_STAGE(PG8_SB(1, 0), cB + kstep, voffB); PG8_STAGE(PG8_SA(1, 0), cA + kstep, voffA); PG8_STAGE(PG8_SB(1, 1), cB + hstep + kstep, voffB);
    PG8_WAIT_V(6); PG8_BAR;
    for (;;) {
        const bool has_next = S.next(ui + 1, nxt);
        const char* nA = has_next ? (const char*)g.A + (size_t)nxt.pm * tstep + (size_t)(nxt.pn / g.pn_per_grp) * g.a_grp_bytes : cA; const char* nB = has_next ? (const char*)g.Bt + (size_t)nxt.pn * tstep : cB;
        for (int t = 0; t < nt; t += 2) {
            const bool last = (t == nt - 2);
            const char* a1 = cA + (size_t)(t + 1) * kstep;
            const char* a2 = last ? nA : cA + (size_t)(t + 2) * kstep; const char* b2 = last ? nB : cB + (size_t)(t + 2) * kstep;
            const char* a3 = a2 + kstep; const char* b3 = b2 + kstep;
            PG8_LDB(B0, 0, 0); PG8_SCHED; PG8_LDA(At, 0, 0); PG8_STAGE(PG8_SA(1, 1), a1 + hstep, voffA);
            PG8_WAIT_L(8); PG8_BAR; PG8_WAIT_L(0); PG8_MMA(0, 0, At, B0); PG8_BAR; PG8_SCHED;
            PG8_LDB(B1, 0, 1); PG8_STAGE(PG8_SB(0, 0), b2, voffB);
            PG8_BAR; PG8_WAIT_L(0); PG8_MMA(0, 1, At, B1); PG8_BAR;
            PG8_LDA(At, 0, 1); PG8_STAGE(PG8_SA(0, 0), a2, voffA);
            PG8_BAR; PG8_WAIT_L(0); PG8_MMA(1, 0, At, B0); PG8_BAR; PG8_SCHED;
            PG8_STAGE(PG8_SB(0, 1), b2 + hstep, voffB);
            PG8_WAIT_V(6); PG8_BAR; PG8_MMA(1, 1, At, B1); PG8_BAR;
            PG8_LDB(B0, 1, 0); PG8_SCHED; PG8_LDA(At, 1, 0); PG8_STAGE(PG8_SA(0, 1), a2 + hstep, voffA);
            PG8_WAIT_L(8); PG8_BAR; PG8_WAIT_L(0); PG8_MMA(0, 0, At, B0); PG8_BAR; PG8_SCHED;
            PG8_LDB(B1, 1, 1); PG8_STAGE(PG8_SB(1, 0), b3, voffB);
            PG8_BAR; PG8_WAIT_L(0); PG8_MMA(0, 1, At, B1); PG8_BAR;
            PG8_LDA(At, 1, 1); PG8_STAGE(PG8_SA(1, 0), a3, voffA);
            PG8_BAR; PG8_WAIT_L(0); PG8_MMA(1, 0, At, B0); PG8_BAR; PG8_SCHED;
            PG8_STAGE(PG8_SB(1, 1), b3 + hstep, voffB);
            PG8_WAIT_V(6); PG8_BAR; PG8_MMA(1, 1, At, B1); PG8_BAR;
        }
        E(acc, cur, wr, wc, fr, fq);
        if (!has_next) break;
        if (!E.keep(cur)) {
#pragma unroll
        for (int a = 0; a < 2; ++a)
#pragma unroll
            for (int b = 0; b < 2; ++b)
#pragma unroll
                for (int m = 0; m < 4; ++m)
#pragma unroll
                    for (int n = 0; n < 2; ++n) acc[a][b][m][n] = (f32x4){0.f, 0.f, 0.f, 0.f};
        }
        cur = nxt; cA = nA; cB = nB; ++ui;
    }
    PG8_WAIT_V(0);
    if (wr == 0) PG8_BAR;
    PG8_BAR;
#undef PG8_SA
#undef PG8_SB
#undef PG8_STAGE
#undef PG8_LDA
#undef PG8_LDB
#undef PG8_MMA
#undef PG8_WAIT_V
#undef PG8_WAIT_L
#undef PG8_BAR
#undef PG8_SCHED
}
}

struct EpiG1 {
    static constexpr bool PERM = true;
    __device__ __forceinline__ bool keep(const pg8::Unit&) const { return false; }
    u16* proj; u16* vT; u16* kiP; unsigned char* gq;
    __device__ __forceinline__ void operator()(f32x4 (&acc)[2][2][4][2], const pg8::Unit& u, int wr, int wc, int fr, int fq) const {
        const int row0 = u.pm * 256 + wr * 64 + fr, cin = wc * 32 + 8 * fq, col0 = u.pn * 256 + cin;
        if (u.pn == 24 || u.pn == 25) {
#pragma unroll
            for (int ai = 0; ai < 2; ++ai)
#pragma unroll
                for (int m = 0; m < 4; ++m) {
                    const int r = row0 + ai * 128 + m * 16, bl = r >> 12, s = r & 4095;
#pragma unroll
                    for (int bj = 0; bj < 2; ++bj)
#pragma unroll
                        for (int n = 0; n < 2; ++n) {
                            const int cv = (u.pn - 24) * 256 + bj * 128 + cin + 4 * n;
                            u16* dst = vT + ((size_t)(bl * 512 + cv)) * 4096 + s;
#pragma unroll
                            for (int j = 0; j < 4; ++j) dst[(size_t)j * 4096] = f2bf(acc[ai][bj][m][n][j]);
                        }
                }
            return;
        }
        if (u.pn >= 28) {
#pragma unroll
            for (int ai = 0; ai < 2; ++ai)
#pragma unroll
                for (int m = 0; m < 4; ++m) {
                    unsigned char* gp = gq + (size_t)(row0 + ai * 128 + m * 16) * 4096 + (u.pn - 28) * 256 + cin;
#pragma unroll
                    for (int bj = 0; bj < 2; ++bj) { unsigned w2[2];
#pragma unroll
                        for (int n = 0; n < 2; ++n) {
                            const f32x4 v = acc[ai][bj][m][n];
                            const unsigned b0 = (unsigned)(sigmoidf_(v[0]) * 255.f + 0.5f), b1 = (unsigned)(sigmoidf_(v[1]) * 255.f + 0.5f),
                                           b2 = (unsigned)(sigmoidf_(v[2]) * 255.f + 0.5f), b3 = (unsigned)(sigmoidf_(v[3]) * 255.f + 0.5f);
                            w2[n] = b0 | (b1 << 8) | (b2 << 16) | (b3 << 24);
                        }
                        u32x2 o = {w2[0], w2[1]}; *(u32x2*)(gp + bj * 128) = o; }
                }
            return;
        }
#pragma unroll
        for (int ai = 0; ai < 2; ++ai)
#pragma unroll
            for (int m = 0; m < 4; ++m) {
                u16* rowp = proj + (size_t)(row0 + ai * 128 + m * 16) * NP + col0;
#pragma unroll
                for (int bj = 0; bj < 2; ++bj) {
                    const f32x4 v0 = acc[ai][bj][m][0], v1 = acc[ai][bj][m][1];
                    u32x4 o = {cvtpk(v0[0], v0[1]), cvtpk(v0[2], v0[3]), cvtpk(v1[0], v1[1]), cvtpk(v1[2], v1[3])};
                    *(u32x4*)(rowp + bj * 128) = o;
                    if (u.pn == 9 && bj == 1 && wc < 2) {
                        const int r = row0 + ai * 128 + m * 16, bl = r >> 12, key = r & 4095;
                        *(u32x4*)(kiP + (((((size_t)bl * 128 + (key >> 5)) * 4 + (cin >> 4)) * 64) + ((cin >> 3) & 1) * 32 + (key & 31)) * 8) = o;
                    }
                }
            }
    }
};
struct EpiG2 {
    static constexpr bool PERM = true;
    const unsigned char* gq; u16* hbuf;
    __device__ __forceinline__ bool keep(const pg8::Unit& u) const { return u.pn < 12; }
    __device__ __forceinline__ void operator()(f32x4 (&acc)[2][2][4][2], const pg8::Unit& u, int wr, int wc, int fr, int fq) const {
        const int row0 = u.pm * 256 + wr * 64 + fr, cin = wc * 32 + 8 * fq; const bool last = (u.pn >= 12);
#pragma unroll
        for (int ai = 0; ai < 2; ++ai) {
            u32x2 ga[4][2], gb[4][2];
#pragma unroll
            for (int m = 0; m < 4; ++m) {
                const unsigned char* gp = gq + (size_t)(row0 + ai * 128 + m * 16) * 4096 + u.pn * 256 + cin;
#pragma unroll
                for (int bj = 0; bj < 2; ++bj) { ga[m][bj] = *(const u32x2*)(gp + bj * 128);
                    gb[m][bj] = last ? (u32x2){0x01010101u, 0x01010101u} : *(const u32x2*)(gp + 1024 + bj * 128); }
            }
#pragma unroll
            for (int m = 0; m < 4; ++m) {
                u16* op = hbuf + (size_t)(row0 + ai * 128 + m * 16) * DM + (u.pn & 3) * 256 + cin;
#pragma unroll
                for (int bj = 0; bj < 2; ++bj) {
                    f32x4 vv[2];
#pragma unroll
                    for (int n = 0; n < 2; ++n) {
                        const unsigned a4 = ga[m][bj][n], b4 = gb[m][bj][n]; f32x4 v = acc[ai][bj][m][n];
#pragma unroll
                        for (int j = 0; j < 4; ++j) { const float ga_ = fmaxf((float)((a4 >> (8 * j)) & 255u), 1.f), gb_ = fmaxf((float)((b4 >> (8 * j)) & 255u), 1.f);
                            v[j] *= last ? ga_ * (1.f / 255.f) : ga_ * __builtin_amdgcn_rcpf(gb_); }
                        vv[n] = v; if (!last) acc[ai][bj][m][n] = v;
                    }
                    if (last) { u32x4 o = {cvtpk(vv[0][0], vv[0][1]), cvtpk(vv[0][2], vv[0][3]), cvtpk(vv[1][0], vv[1][1]), cvtpk(vv[1][2], vv[1][3])}; *(u32x4*)(op + bj * 128) = o; }
                }
            }
        }
    }
};
struct EpiG3 {
    static constexpr bool PERM = true;
    __device__ __forceinline__ bool keep(const pg8::Unit&) const { return false; }
    const float* resid; float* out; int tok0;
    __device__ __forceinline__ void operator()(f32x4 (&acc)[2][2][4][2], const pg8::Unit& u, int wr, int wc, int fr, int fq) const {
        const int row0 = tok0 + u.pm * 256 + wr * 64 + fr, col0 = u.pn * 256 + wc * 32 + 8 * fq;
#pragma unroll
        for (int ai = 0; ai < 2; ++ai) {
            f32x4 rv[4][2][2];
#pragma unroll
            for (int m = 0; m < 4; ++m) { const size_t ro = (size_t)(row0 + ai * 128 + m * 16) * DM + col0;
#pragma unroll
                for (int bj = 0; bj < 2; ++bj)
#pragma unroll
                    for (int n = 0; n < 2; ++n) rv[m][bj][n] = *(const f32x4*)(resid + ro + bj * 128 + n * 4); }
#pragma unroll
            for (int m = 0; m < 4; ++m) { const size_t ro = (size_t)(row0 + ai * 128 + m * 16) * DM + col0;
#pragma unroll
                for (int bj = 0; bj < 2; ++bj)
#pragma unroll
                    for (int n = 0; n < 2; ++n) *(f32x4*)(out + ro + bj * 128 + n * 4) = rv[m][bj][n] + acc[ai][bj][m][n]; }
        }
    }
};

__device__ __forceinline__ int win_src(int j) {
    if (j < 1536) return j;
    if (j < 2048) return -2;
    if (j < 2500) return j;
    if (j < 2504) return 6596 + (j - 2500);
    if (j < 2560) return -1;
    if (j < 3072) return 2500 + (j - 2560);
    if (j < 5120) return 3012 + (j - 3072);
    if (j < 6656) return 5060 + (j - 5120);
    if (j < 7168) return 6600 + (j - 6656);
    return 7112 + (j - 7168);
}
__device__ __forceinline__ void tr_tile(const float* src, int ldS, u16* dst, int ldD, int n0, int k0, bool wmap, const float* rs, LAS float* tile) {
    const int tid = opq(threadIdx.x);
    { const int nn = tid & 63, kr = tid >> 6; int sc = n0 + nn; if (wmap) sc = win_src(sc);
#pragma unroll
      for (int i = 0; i < 8; ++i) { const int k = kr + 8 * i; float v = 0.f; if (sc >= 0) { v = src[(size_t)(k0 + k) * ldS + sc]; if (rs) v *= rs[k0 + k]; } tile[k * 65 + nn] = v; } }
    __syncthreads();
    { const int kk = (tid & 31) * 2, nr = tid >> 5;
#pragma unroll
      for (int i = 0; i < 4; ++i) { const int n = nr + 16 * i; *(unsigned*)(dst + (size_t)(n0 + n) * ldD + k0 + kk) = cvtpk(tile[kk * 65 + n], tile[(kk + 1) * 65 + n]); } }
    __syncthreads();
}
__device__ __forceinline__ void step_prep(const Params& p, int l, LAS unsigned char* lds) {
    LAS float* tile = (LAS float*)lds;
    const int nb = gridDim.x, b = blockIdx.x, tid = opq(threadIdx.x);
    for (int it = b; it < 3856; it += nb) {
        if (it < 2816) { const int ntile = it / 16, kt = it % 16; if (ntile >= 24 && ntile < 32) continue;
            tr_tile(p.w_in + (size_t)l * DM * INW, INW, p.Wt, DM, ntile * 64, kt * 64, true, nullptr, tile); }
        else if (it < 3328) { const int j = it - 2816, n = j / 128, r = j % 128, dt = r / 8, wt = r % 8;
            tr_tile(p.w_branch + ((size_t)(l * 4 + n)) * 512 * DM, DM, p.Wb + (size_t)n * DM * 512, 512, dt * 64, wt * 64, false, nullptr, tile); }
        else if (it < 3584) { const int j = it - 3328, ntile = j / 16, kt = j % 16;
            tr_tile(p.w_out + (size_t)l * DM * DM, DM, p.Wo, DM, ntile * 64, kt * 64, false, nullptr, tile); }
        else if (it < 3600) { const int j = it - 3584, h = j / 4, dt = (j % 4) / 2, lt = j % 2;
            tr_tile(p.dsa_w_uv + ((size_t)(l * 4 + h)) * 128 * 128, 128, p.WuvT + (size_t)h * 128 * 128, 128, dt * 64, lt * 64, false, p.dsa_kv_g + l * 128, tile); }
        else { const int j = it - 3600, h = j & 3, kb = j >> 2;
            LAS float* wuk = (LAS float*)lds;
            for (int i = tid; i < 128 * 128; i += 512) wuk[(i >> 7) * 129 + (i & 127)] = p.dsa_w_uk[((size_t)(l * 4 + h)) * 16384 + i];
            __syncthreads();
            const int lat = tid & 127, kq = tid >> 7; const float gk = p.dsa_kv_g[l * 128 + lat];
            for (int kk = 0; kk < 4; ++kk) { const int k = kb * 16 + kq * 4 + kk; const float* wr_ = p.w_in + ((size_t)l * DM + k) * INW + 1536 + h * 128;
                float a = 0.f;
#pragma unroll 8
                for (int d = 0; d < 128; ++d) a += wr_[d] * wuk[lat * 129 + d];
                p.Wt[(size_t)(C_QL + h * 128 + lat) * DM + k] = f2bf(a * gk); }
            __syncthreads(); }
    }
}
__device__ __forceinline__ void step_norm(const Params& p, int l, int g) {
    const float* src = (l == 0) ? p.x : p.out; const float* gw = p.norm_g + l * DM;
    const int tidq = opq(threadIdx.x), wid = tidq >> 6, lane = tidq & 63, gwv = blockIdx.x * 8 + wid, nwv = gridDim.x * 8;
    for (int r = gwv; r < MG; r += nwv) {
        const float* xr = src + (size_t)(g * MG + r) * DM; f32x4 v[4]; float ss = 0.f;
#pragma unroll
        for (int i = 0; i < 4; ++i) { v[i] = *(const f32x4*)(xr + lane * 4 + 256 * i); ss += v[i][0] * v[i][0] + v[i][1] * v[i][1] + v[i][2] * v[i][2] + v[i][3] * v[i][3]; }
        ss = wave_sum(ss); const float rstd = rsqrtf(ss * (1.f / DM) + EPS);
#pragma unroll
        for (int i = 0; i < 4; ++i) { const f32x4 gv = *(const f32x4*)(gw + lane * 4 + 256 * i);
            u32x2 o = {cvtpk(v[i][0] * rstd * gv[0], v[i][1] * rstd * gv[1]), cvtpk(v[i][2] * rstd * gv[2], v[i][3] * rstd * gv[3])};
            *(u32x2*)(p.hbuf + (size_t)r * DM + lane * 4 + 256 * i) = o; }
    }
}
__device__ __forceinline__ void step_final(const Params& p) {
    const int tidq = opq(threadIdx.x), wid = tidq >> 6, lane = tidq & 63, gwv = blockIdx.x * 8 + wid, nwv = gridDim.x * 8;
    for (int r = gwv; r < 32768; r += nwv) {
        float* xr = p.out + (size_t)r * DM; f32x4 v[4]; float ss = 0.f;
#pragma unroll
        for (int i = 0; i < 4; ++i) { v[i] = *(const f32x4*)(xr + lane * 4 + 256 * i); ss += v[i][0] * v[i][0] + v[i][1] * v[i][1] + v[i][2] * v[i][2] + v[i][3] * v[i][3]; }
        ss = wave_sum(ss); const float rstd = rsqrtf(ss * (1.f / DM) + EPS);
#pragma unroll
        for (int i = 0; i < 4; ++i) { const f32x4 gv = *(const f32x4*)(p.final_g + lane * 4 + 256 * i); *(f32x4*)(xr + lane * 4 + 256 * i) = v[i] * rstd * gv; }
    }
}
__device__ __forceinline__ void step_merge(const Params& p) {
    const int gt = blockIdx.x * 512 + opq(threadIdx.x), nth = gridDim.x * 512;
    for (int i = gt; i < MG * 128; i += nth) {
        const int r = i >> 7, c = (i & 127) * 8; const u16* base = p.proj + (size_t)r * NP + c; float s[8];
        { const u32x4 a = *(const u32x4*)base;
#pragma unroll
          for (int e = 0; e < 4; ++e) { s[2 * e] = bflo(a[e]); s[2 * e + 1] = bfhi(a[e]); } }
#pragma unroll
        for (int n = 1; n < 4; ++n) { const u32x4 a = *(const u32x4*)(base + n * 1024);
#pragma unroll
            for (int e = 0; e < 4; ++e) { s[2 * e] += bflo(a[e]); s[2 * e + 1] += bfhi(a[e]); } }
        u32x4 o = {cvtpk(s[0], s[1]), cvtpk(s[2], s[3]), cvtpk(s[4], s[5]), cvtpk(s[6], s[7])};
        *(u32x4*)(p.hbuf + (size_t)r * DM + c) = o;
    }
}

constexpr int D_K0 = 0, D_K1 = 17408, D_V0 = 34816, D_V1 = 53248, D_V2 = 71680, D_CUM = 90112, D_WS = 106496;
__device__ __forceinline__ void item_fox(const Params& p, int l, int bl, int h, int qb, LAS unsigned char* lds) {
    const int tid = opq(threadIdx.x), wid = __builtin_amdgcn_readfirstlane(tid >> 6), lane = tid & 63, c32 = lane & 31, hi = lane >> 5;
    const int nk = (qb + 1) * 256, ntile = nk / 64;
    const u16* prow = p.proj + (size_t)bl * SEQ * NP;
    LAS float* cumL = (LAS float*)(lds + D_CUM); LAS float* wsum = (LAS float*)(lds + D_WS);
    const float LOG2E = 1.4426950408889634f;
    { const float bf = p.fox_b_f[l * 4 + h]; float v[8], tot = 0.f;
#pragma unroll
      for (int i = 0; i < 8; ++i) { const int s = tid * 8 + i; float ls = 0.f;
          if (s < nk) { const float xx = bf2f(prow[(size_t)s * NP + C_DF + h]) + bf; ls = fminf(xx, 0.f) - log1pf(__expf(-fabsf(xx))); }
          tot += ls; v[i] = tot; }
      float incl = tot;
#pragma unroll
      for (int o = 1; o < 64; o <<= 1) { const float y = __shfl_up(incl, o); if (lane >= o) incl += y; }
      if (lane == 63) wsum[wid] = incl;
      __syncthreads();
      float woff = 0.f; for (int w = 0; w < wid; ++w) woff += wsum[w];
      const float base = woff + incl - tot;
#pragma unroll
      for (int i = 0; i < 8; ++i) cumL[tid * 8 + i] = -(base + v[i]) * LOG2E; }
    const int qrow = qb * 256 + wid * 32 + c32;
    bf16x8 Qf[8];
    { const u16* qp = prow + (size_t)qrow * NP + C_DQ + h * 128 + 8 * hi;
#pragma unroll
      for (int ks = 0; ks < 8; ++ks) Qf[ks] = *(const bf16x8*)(qp + ks * 16); }
    const u16* kg = prow + C_DK + h * 128; const u16* vg = p.vT + ((size_t)(bl * 4 + h)) * 128 * 4096;
    u32x4 st[4];
    auto gload = [&](int kt) {
#pragma unroll
        for (int i = 0; i < 2; ++i) { const int c = tid + 512 * i; st[i] = *(const u32x4*)(kg + (size_t)(kt * 64 + (c >> 4)) * NP + (c & 15) * 8); }
#pragma unroll
        for (int i = 0; i < 2; ++i) { const int c = tid + 512 * i; st[2 + i] = *(const u32x4*)(vg + (size_t)(c >> 3) * 4096 + kt * 64 + (c & 7) * 8); }
    };
    auto vbuf = [&](int kt) -> LAS unsigned char* { const int r = kt % 3; return lds + (r == 0 ? D_V0 : (r == 1 ? D_V1 : D_V2)); };
    auto lstore = [&](int kt) {
        LAS unsigned char* kb = lds + ((kt & 1) ? D_K1 : D_K0); LAS unsigned char* vb = vbuf(kt);
#pragma unroll
        for (int i = 0; i < 2; ++i) { const int c = tid + 512 * i; *(LAS u32x4*)(kb + (c >> 4) * 272 + (c & 15) * 16) = st[i]; }
#pragma unroll
        for (int i = 0; i < 2; ++i) { const int c = tid + 512 * i; *(LAS u32x4*)(vb + (c >> 3) * 144 + (c & 7) * 16) = st[2 + i]; }
    };
    gload(0); lstore(0);
    __syncthreads();
    f32x16 O[4];
#pragma unroll
    for (int i = 0; i < 4; ++i)
#pragma unroll
        for (int r = 0; r < 16; ++r) O[i][r] = 0.f;
    float mrun = -1e30f, lrun = 0.f;
    const int rowA = (c32 & 0x13) | ((c32 & 4) << 1) | ((c32 & 8) >> 1);
    const float C2 = 0.08838834764831845f * LOG2E;
    const int qw_lo = qb * 256 + wid * 32;
    u32x4 Pk[4];
    auto qk_sm = [&](int kt) {
        const int k0 = kt * 64;
        LAS unsigned char* kb = lds + ((kt & 1) ? D_K1 : D_K0);
        f32x16 S0, S1;
#pragma unroll
        for (int r = 0; r < 16; ++r) { S0[r] = 0.f; S1[r] = 0.f; }
#pragma unroll
        for (int ks = 0; ks < 8; ++ks) {
            const bf16x8 a0 = *(const LAS bf16x8*)(kb + rowA * 272 + ks * 32 + hi * 16);
            const bf16x8 a1 = *(const LAS bf16x8*)(kb + (rowA + 32) * 272 + ks * 32 + hi * 16);
            S0 = __builtin_amdgcn_mfma_f32_32x32x16_bf16(a0, Qf[ks], S0, 0, 0, 0);
            S1 = __builtin_amdgcn_mfma_f32_32x32x16_bf16(a1, Qf[ks], S1, 0, 0, 0);
        }
        const int kb0 = k0 + 8 * hi;
#pragma unroll
        for (int q4 = 0; q4 < 4; ++q4) {
            const f32x4 c0 = *(const LAS f32x4*)(cumL + kb0 + (q4 & 1) * 4 + (q4 >> 1) * 16);
            const f32x4 c1 = *(const LAS f32x4*)(cumL + kb0 + 32 + (q4 & 1) * 4 + (q4 >> 1) * 16);
#pragma unroll
            for (int j = 0; j < 4; ++j) { const int r = q4 * 4 + j; S0[r] = fmaf(S0[r], C2, c0[j]); S1[r] = fmaf(S1[r], C2, c1[j]); }
        }
        if (k0 + 63 > qw_lo) {
            const int dq = qrow - kb0;
#pragma unroll
            for (int r = 0; r < 16; ++r) { const int ko = (r & 7) + 16 * (r >> 3); if (ko > dq) S0[r] = -__builtin_inff(); if (ko + 32 > dq) S1[r] = -__builtin_inff(); }
        }
        float mx = S0[0];
#pragma unroll
        for (int r = 1; r < 16; ++r) mx = fmaxf(mx, S0[r]);
#pragma unroll
        for (int r = 0; r < 16; ++r) mx = fmaxf(mx, S1[r]);
        mx = fmaxf(mx, __shfl_xor(mx, 32));
        const float mnew = fmaxf(mrun, mx), alpha = __builtin_amdgcn_exp2f(mrun - mnew); mrun = mnew;
        float ps = 0.f;
#pragma unroll
        for (int r = 0; r < 16; ++r) { S0[r] = __builtin_amdgcn_exp2f(S0[r] - mnew); S1[r] = __builtin_amdgcn_exp2f(S1[r] - mnew); ps += S0[r] + S1[r]; }
        lrun = lrun * alpha + ps;
#pragma unroll
        for (int i = 0; i < 4; ++i) O[i] *= alpha;
#pragma unroll
        for (int j = 0; j < 2; ++j)
#pragma unroll
            for (int e = 0; e < 4; ++e) { Pk[j][e] = cvtpk(S0[8 * j + 2 * e], S0[8 * j + 2 * e + 1]); Pk[2 + j][e] = cvtpk(S1[8 * j + 2 * e], S1[8 * j + 2 * e + 1]); }
    };
    auto pv = [&](LAS unsigned char* vb) {
#pragma unroll
        for (int sub = 0; sub < 2; ++sub)
#pragma unroll
            for (int j = 0; j < 2; ++j) {
                const bf16x8 Pf = *reinterpret_cast<const bf16x8*>(&Pk[sub * 2 + j]);
#pragma unroll
                for (int db = 0; db < 4; ++db) {
                    const bf16x8 vf = *(const LAS bf16x8*)(vb + (32 * db + c32) * 144 + (32 * sub + 16 * j + 8 * hi) * 2);
                    O[db] = __builtin_amdgcn_mfma_f32_32x32x16_bf16(vf, Pf, O[db], 0, 0, 0);
                }
            }
    };
    const bool late = wid >= 4; bool pvalid = false;
    for (int kt = 0; kt < ntile; ++kt) {
        if (kt + 1 < ntile) gload(kt + 1);
        const bool rel = kt * 64 <= qw_lo + 31;
        if (late && pvalid) pv(vbuf(kt - 1));
        if (rel) qk_sm(kt);
        if (!late && rel) pv(vbuf(kt));
        pvalid = rel;
        if (kt + 1 < ntile) lstore(kt + 1);
        __syncthreads();
    }
    if (late && pvalid) pv(vbuf(ntile - 1));
    { const float lt = lrun + __shfl_xor(lrun, 32), inv = 1.f / lt;
      const size_t grow = (size_t)(bl * SEQ + qrow);
      const u16* zp = p.proj + grow * NP + C_DZ + h * 128; u16* yp = p.ybuf + ((size_t)3 * MG + grow) * 512 + h * 128;
#pragma unroll
      for (int db = 0; db < 4; ++db)
#pragma unroll
          for (int r4 = 0; r4 < 4; ++r4) {
              const int d0 = 32 * db + 8 * r4 + 4 * hi; const u32x2 z = *(const u32x2*)(zp + d0);
              const float o0 = O[db][4 * r4] * inv * siluf_(bflo(z[0])), o1 = O[db][4 * r4 + 1] * inv * siluf_(bfhi(z[0])),
                          o2 = O[db][4 * r4 + 2] * inv * siluf_(bflo(z[1])), o3 = O[db][4 * r4 + 3] * inv * siluf_(bfhi(z[1]));
              u32x2 o = {cvtpk(o0, o1), cvtpk(o2, o3)}; *(u32x2*)(yp + d0) = o; } }
    __syncthreads();
}

constexpr int B_OLAT = 131072;
__device__ __forceinline__ unsigned sortable(float f) { const unsigned b = __float_as_uint(f); return (b & 0x80000000u) ? ~b : (b | 0x80000000u); }
__device__ __forceinline__ void item_dsa(const Params& p, int bl, int rq, LAS unsigned char* lds, int sm = 63) {
    const int tid = opq(threadIdx.x), wid = __builtin_amdgcn_readfirstlane(tid >> 6), lane = tid & 63;
    const int t0 = rq * 8, nmax = t0 + 8, ntile32 = (nmax + 31) >> 5;
    const u16* prow = p.proj + (size_t)bl * SEQ * NP;
    LAS float* sc = (LAS float*)lds;
    { const int c32 = lane & 31, hi = lane >> 5;
      bf16x8 qa[4];
      { const u16* qp = prow + (size_t)(t0 + (c32 >> 2)) * NP + C_QI + (c32 & 3) * 64 + 8 * hi;
#pragma unroll
        for (int ks = 0; ks < 4; ++ks) qa[ks] = *(const bf16x8*)(qp + ks * 16); }
      float wv[16];
#pragma unroll
      for (int r = 0; r < 16; ++r) wv[r] = 0.5f * bf2f(prow[(size_t)(t0 + 2 * (r >> 2) + hi) * NP + C_WI + (r & 3)]);
#pragma unroll
      for (int r = 0; r < 16; ++r) wv[r] *= 0.125f;
      auto ldb = [&](bf16x8 (&kk)[4][4], int i0) {
#pragma unroll
          for (int j = 0; j < 4; ++j) { int T = wid + 8 * (i0 + j); T = T < ntile32 ? T : ntile32 - 1; const u16* kp = p.kiP + (((size_t)bl * 128 + T) * 256 + lane) * 8;
#pragma unroll
              for (int ks = 0; ks < 4; ++ks) kk[j][ks] = *(const bf16x8*)(kp + ks * 512); } };
      auto comp = [&](const bf16x8 (&kk)[4][4], int i0) {
#pragma unroll
          for (int j = 0; j < 4; ++j) {
              const int T = wid + 8 * (i0 + j);
              if (T < ntile32) {
                  const int key = T * 32 + c32;
                  f32x16 a;
#pragma unroll
                  for (int r = 0; r < 16; ++r) a[r] = 0.f;
#pragma unroll
                  for (int ks = 0; ks < 4; ++ks) a = __builtin_amdgcn_mfma_f32_32x32x16_bf16(qa[ks], kk[j][ks], a, 0, 0, 0);
#pragma unroll
                  for (int g4 = 0; g4 < 4; ++g4) { float s = 0.f;
#pragma unroll
                      for (int hh = 0; hh < 4; ++hh) s = fmaf(wv[4 * g4 + hh], fmaxf(a[4 * g4 + hh], 0.f), s);
                      sc[(2 * g4 + hi) * 4096 + key] = s; }
              }
          } };
      if (sm & 1) {
          const int nT = (ntile32 - wid + 7) >> 3;
          bf16x8 ka[4][4], kc[4][4];
          ldb(ka, 0);
          for (int i0 = 0; i0 < nT; i0 += 8) { ldb(kc, i0 + 4); comp(ka, i0); ldb(ka, i0 + 8); comp(kc, i0 + 4); }
      } }
    __syncthreads();
    const int pos = t0 + wid, n = pos + 1, kcount = n < 256 ? n : 256;
    const size_t qgrow = (size_t)pos;
    LAS unsigned char* wbase = lds + wid * 16384;
    LAS unsigned char* aux = lds + B_OLAT + wid * 2048;
    LAS u16* list = (LAS u16*)aux; LAS float* pbuf = (LAS float*)(aux + 1024); LAS float* alf = (LAS float*)(aux + 640);
    { unsigned u[64];
      LAS float* srow = sc + wid * 4096;
#pragma unroll
      for (int r = 0; r < 64; ++r) { u[r] = 0u; if (r * 64 < n) { const float f = srow[r * 64 + lane]; u[r] = (r * 64 + lane < n) ? sortable(f) : 0u; } }
      const int nreg = (n + 63) >> 6;
      unsigned T = 1u; int need = 0, E = 0;
#define CNT_GE(dst, thr) do { _Pragma("unroll") for (int rb = 0; rb < 8; ++rb) { if (rb * 8 < nreg) { \
          unsigned long long m0_, m1_, m2_, m3_, m4_, m5_, m6_, m7_; \
          asm("v_cmp_ge_u32_e64 %0, %8, %16\n\tv_cmp_ge_u32_e64 %1, %9, %16\n\tv_cmp_ge_u32_e64 %2, %10, %16\n\tv_cmp_ge_u32_e64 %3, %11, %16\n\t" \
              "v_cmp_ge_u32_e64 %4, %12, %16\n\tv_cmp_ge_u32_e64 %5, %13, %16\n\tv_cmp_ge_u32_e64 %6, %14, %16\n\tv_cmp_ge_u32_e64 %7, %15, %16" \
              : "=&s"(m0_), "=&s"(m1_), "=&s"(m2_), "=&s"(m3_), "=&s"(m4_), "=&s"(m5_), "=&s"(m6_), "=&s"(m7_) \
              : "v"(u[rb * 8]), "v"(u[rb * 8 + 1]), "v"(u[rb * 8 + 2]), "v"(u[rb * 8 + 3]), "v"(u[rb * 8 + 4]), "v"(u[rb * 8 + 5]), "v"(u[rb * 8 + 6]), "v"(u[rb * 8 + 7]), "s"(thr)); \
          dst += __builtin_popcountll(m0_) + __builtin_popcountll(m1_) + __builtin_popcountll(m2_) + __builtin_popcountll(m3_) \
               + __builtin_popcountll(m4_) + __builtin_popcountll(m5_) + __builtin_popcountll(m6_) + __builtin_popcountll(m7_); } } } while (0)
      if (n > 256 && (sm & 2)) {
          unsigned kp[32]; unsigned basek = 0u; const unsigned ones2 = 0x00010001u;
#pragma unroll
          for (int r2 = 0; r2 < 32; ++r2) { kp[r2] = (u[2 * r2] >> 17) | ((u[2 * r2 + 1] >> 1) & 0x7fff0000u);
              asm("v_dot2_u32_u16 %0, %1, %2, %0" : "+v"(basek) : "v"(kp[r2]), "v"(ones2)); }
          const int nblk = (nreg + 7) >> 3;
          unsigned T15 = 0u; bool exact = false; int cntT = n;
          for (int bit = 14; bit >= 0; --bit) {
              const unsigned c = T15 | (1u << bit), cpk = (c - 1u) * 0x00010001u; unsigned acc = 0u;
#pragma unroll
              for (int rb = 0; rb < 8; ++rb) { if (rb < nblk) {
#pragma unroll
                  for (int r2 = rb * 4; r2 < rb * 4 + 4; ++r2) { unsigned d; asm("v_pk_sub_u16 %0, %1, %2" : "=v"(d) : "v"(cpk), "v"(kp[r2]));
                      asm("v_dot2_u32_u16 %0, %1, %2, %0" : "+v"(acc) : "v"(d), "v"(ones2)); } } }
              const unsigned cl = (acc - (unsigned)(8 * nblk) * (c - 1u) + basek) >> 16;
              int cnt = 0;
#pragma unroll
              for (int b_ = 0; b_ < 7; ++b_) cnt += __builtin_popcountll(__ballot((cl >> b_) & 1u)) << b_;
              if (cnt >= 256) { T15 = c; cntT = cnt; }
              if (cnt == 256) { exact = true; break; }
          }
          T = T15 << 17;
          if (!exact) for (int bit = 16; bit >= 0; --bit) {
              const unsigned cand = T | (1u << bit); int cnt = 0;
              CNT_GE(cnt, cand);
              if (cnt >= 256) { T = cand; cntT = cnt; }
              if (cnt == 256) break;
          }
          if (cntT == 256) { need = 1; E = 1; }
          else { int cgt = 0; const unsigned T1 = T + 1u;
              CNT_GE(cgt, T1); need = 256 - cgt; E = cntT - cgt; }
      }
      if (sm & 4) {
        if (E == need) {
          int c = 0;
#pragma unroll
          for (int rb = 0; rb < 8; ++rb) { if (rb * 8 < nreg) {
#pragma unroll
              for (int r = rb * 8; r < rb * 8 + 8; ++r) c += (u[r] >= T) ? 1 : 0; } }
          int incl = c;
#pragma unroll
          for (int o = 1; o < 64; o <<= 1) { const int y = __shfl_up(incl, o); if (lane >= o) incl += y; }
          int off = incl - c;
#pragma unroll
          for (int rb = 0; rb < 8; ++rb) { if (rb * 8 < nreg) {
#pragma unroll
              for (int r = rb * 8; r < rb * 8 + 8; ++r) { const bool sel = u[r] >= T; list[sel ? off : 256 + lane] = (u16)(r * 64 + lane); off += sel ? 1 : 0; } } }
        } else {
          int outp = 0, tie = 0;
#pragma unroll
          for (int r = 0; r < 64; ++r) {
              if (r * 64 < n) {
                  const bool gt = u[r] > T, eq = (u[r] == T);
                  const unsigned long long meq = __ballot(eq);
                  const int rank = tie + __builtin_amdgcn_mbcnt_hi((unsigned)(meq >> 32), __builtin_amdgcn_mbcnt_lo((unsigned)meq, 0));
                  const bool s = gt || (eq && rank < need);
                  const unsigned long long ms = __ballot(s);
                  const int slot = outp + __builtin_amdgcn_mbcnt_hi((unsigned)(ms >> 32), __builtin_amdgcn_mbcnt_lo((unsigned)ms, 0));
                  if (s) list[slot] = (u16)(r * 64 + lane);
                  outp += __builtin_popcountll(ms); tie += __builtin_popcountll(meq);
              }
          }
        }
      }
#undef CNT_GE
#pragma unroll
      for (int i = 0; i < 4; ++i) { const int slot = i * 64 + lane; if (slot >= kcount) list[slot] = 0; }
    }
    { const int c16 = lane & 15, quad = lane >> 4;
      typedef unsigned short u16x4 __attribute__((ext_vector_type(4)));
      bf16x8 qa[4];
      { const u16* qp = prow + qgrow * NP + C_QL + (c16 & 3) * 128 + quad * 8;
#pragma unroll
        for (int ks = 0; ks < 4; ++ks) qa[ks] = *(const bf16x8*)(qp + ks * 32); }
      f32x4 oacc[8];
#pragma unroll
      for (int c = 0; c < 8; ++c) oacc[c] = (f32x4){0.f, 0.f, 0.f, 0.f};
      const unsigned fsw = ((c16 & 3) << 2) | (c16 >> 2);
      const unsigned wb = (unsigned)(unsigned long long)wbase;
      unsigned tra[8][2];
      { const unsigned q4 = c16 >> 2, p4 = c16 & 3;
#pragma unroll
        for (int t = 0; t < 2; ++t) { const unsigned fv = (q4 << 2) | ((2 * quad + t) & 3), rowb = wb + (8 * quad + 4 * t + q4) * 256 + 8 * (p4 & 1);
#pragma unroll
            for (int c = 0; c < 8; ++c) tra[c][t] = rowb + 16 * ((2 * c + (p4 >> 1)) ^ fv); } }
      LAS u16* pbT = (LAS u16*)pbuf;
      float mrun = -1e30f, lsum = 0.f;
      const int nb = (sm & 8) ? ((kcount + 63) >> 6) : 0;
      u32x4 w[4][4];
      auto gl = [&](int b) {
#pragma unroll
          for (int jj = 0; jj < 4; ++jj) { const int kx = list[(b * 4 + jj) * 16 + c16] & 4095; const u16* cp = prow + (size_t)kx * NP + C_BC + quad * 8;
#pragma unroll
              for (int ks = 0; ks < 4; ++ks) w[jj][ks] = *(const u32x4*)(cp + ks * 32); } };
      if (nb > 0) gl(0);
      for (int b = 0; b < nb; ++b) {
          float lgv[4], rsv[4];
#pragma unroll
          for (int jj = 0; jj < 4; ++jj) {
              const int rho = jj * 16 + c16, slot = b * 64 + rho;
              f32x4 a = {0.f, 0.f, 0.f, 0.f}; float ss = 0.f;
#pragma unroll
              for (int ks = 0; ks < 4; ++ks) {
#pragma unroll
                  for (int e = 0; e < 4; ++e) asm("v_dot2_f32_bf16 %0, %1, %1, %0" : "+v"(ss) : "v"(w[jj][ks][e]));
                  a = __builtin_amdgcn_mfma_f32_16x16x32_bf16(qa[ks], *reinterpret_cast<const bf16x8*>(&w[jj][ks]), a, 0, 0, 0);
                  *(LAS u32x4*)(wbase + rho * 256 + (((ks * 4 + quad) ^ fsw) << 4)) = w[jj][ks]; }
              ss += __shfl_xor(ss, 16); ss += __shfl_xor(ss, 32);
              const float rstd = rsqrtf(ss * (1.f / 128.f) + EPS);
              const float av = quad == 0 ? a[0] : (quad == 1 ? a[1] : (quad == 2 ? a[2] : a[3]));
              rsv[jj] = rstd; lgv[jj] = (slot < kcount) ? av * rstd * 0.08838834764831845f : -__builtin_inff();
          }
          if (b + 1 < nb) gl(b + 1);
          float mx = fmaxf(fmaxf(lgv[0], lgv[1]), fmaxf(lgv[2], lgv[3]));
#pragma unroll
          for (int o = 1; o < 16; o <<= 1) mx = fmaxf(mx, __shfl_xor(mx, o));
          const float mnew = fmaxf(mrun, mx), alpha = __expf(mrun - mnew); mrun = mnew;
          float ps = 0.f;
#pragma unroll
          for (int jj = 0; jj < 4; ++jj) { const float pe = __expf(lgv[jj] - mnew); ps += pe; pbT[quad * 64 + jj * 16 + c16] = f2bf(pe * rsv[jj]); }
          lsum = lsum * alpha + ps;
          if (c16 == 0) alf[quad] = alpha;
          const f32x4 al4 = *(const LAS f32x4*)alf;
#pragma unroll
          for (int c = 0; c < 8; ++c) oacc[c] *= al4;
#pragma unroll
          for (int ks = 0; ks < 2; ++ks) {
              const bf16x8 pf = *(const LAS bf16x8*)(pbT + (c16 & 3) * 64 + ks * 32 + quad * 8);
              u16x4 t0[8], t1[8];
#define TRR8(dst, tt, OFF) asm volatile("ds_read_b64_tr_b16 %0, %8 offset:" #OFF "\n\tds_read_b64_tr_b16 %1, %9 offset:" #OFF "\n\tds_read_b64_tr_b16 %2, %10 offset:" #OFF "\n\tds_read_b64_tr_b16 %3, %11 offset:" #OFF "\n\t" \
                  "ds_read_b64_tr_b16 %4, %12 offset:" #OFF "\n\tds_read_b64_tr_b16 %5, %13 offset:" #OFF "\n\tds_read_b64_tr_b16 %6, %14 offset:" #OFF "\n\tds_read_b64_tr_b16 %7, %15 offset:" #OFF "\n\ts_waitcnt lgkmcnt(0)" \
                  : "=&v"(dst[0]), "=&v"(dst[1]), "=&v"(dst[2]), "=&v"(dst[3]), "=&v"(dst[4]), "=&v"(dst[5]), "=&v"(dst[6]), "=&v"(dst[7]) \
                  : "v"(tra[0][tt]), "v"(tra[1][tt]), "v"(tra[2][tt]), "v"(tra[3][tt]), "v"(tra[4][tt]), "v"(tra[5][tt]), "v"(tra[6][tt]), "v"(tra[7][tt]) : "memory")
              if (ks == 0) { TRR8(t0, 0, 0); TRR8(t1, 1, 0); } else { TRR8(t0, 0, 8192); TRR8(t1, 1, 8192); }
#undef TRR8
#pragma unroll
              for (int c = 0; c < 8; ++c) {
                  const bf16x8 bf = {(short)t0[c][0], (short)t0[c][1], (short)t0[c][2], (short)t0[c][3], (short)t1[c][0], (short)t1[c][1], (short)t1[c][2], (short)t1[c][3]};
                  oacc[c] = __builtin_amdgcn_mfma_f32_16x16x32_bf16(pf, bf, oacc[c], 0, 0, 0);
              }
          }
      }
#pragma unroll
      for (int o = 1; o < 16; o <<= 1) lsum += __shfl_xor(lsum, o);
      if (c16 == 0) alf[quad] = 1.f / lsum;
      const f32x4 il4 = *(const LAS f32x4*)alf;
      LAS u16* olat = (LAS u16*)wbase;
#pragma unroll
      for (int c = 0; c < 8; ++c) {
          if ((c >> 1) == quad) {
#pragma unroll
              for (int hh = 0; hh < 4; ++hh) olat[hh * 128 + c * 16 + c16] = f2bf(oacc[c][hh] * il4[hh]);
          }
      }
    }
    { const int c16 = lane & 15, quad = lane >> 4, hh = wid >> 1;
      bf16x8 wf[4][4]; u16 zv[4][4];
#pragma unroll
      for (int i = 0; i < 4; ++i) { const int d = ((wid & 1) * 4 + i) * 16 + c16; const u16* wp = p.WuvT + ((size_t)hh * 128 + d) * 128 + quad * 8;
#pragma unroll
          for (int ks = 0; ks < 4; ++ks) wf[i][ks] = *(const bf16x8*)(wp + ks * 32);
#pragma unroll
          for (int j = 0; j < 4; ++j) zv[i][j] = p.proj[(size_t)(bl * SEQ + t0 + 4 * (quad & 1) + j) * NP + C_BZ + hh * 128 + d]; }
      __syncthreads();
      if (sm & 32) {
          LAS u16* olat = (LAS u16*)(lds + (c16 & 7) * 16384);
          bf16x8 af[4];
#pragma unroll
          for (int ks = 0; ks < 4; ++ks) af[ks] = *(const LAS bf16x8*)(olat + hh * 128 + ks * 32 + quad * 8);
#pragma unroll
          for (int i = 0; i < 4; ++i) {
              const int d = ((wid & 1) * 4 + i) * 16 + c16;
              f32x4 a = {0.f, 0.f, 0.f, 0.f};
#pragma unroll
              for (int ks = 0; ks < 4; ++ks) a = __builtin_amdgcn_mfma_f32_16x16x32_bf16(af[ks], wf[i][ks], a, 0, 0, 0);
              if (quad < 2 && sm == 63) {
#pragma unroll
                  for (int j = 0; j < 4; ++j) { const size_t grow = (size_t)(bl * SEQ + t0 + 4 * quad + j);
                      p.ybuf[((size_t)1 * MG + grow) * 512 + hh * 128 + d] = f2bf(a[j] * siluf_(bf2f(zv[i][j]))); }
              }
          }
      }
    }
    __syncthreads();
}

__device__ __forceinline__ void item_gate(const Params& p, int l, int bl, int ch, LAS unsigned char* lds) {
    const int tid = opq(threadIdx.x); const size_t r0 = (size_t)bl * SEQ + ch * 128;
    LAS float* stats = (LAS float*)lds;
    { const int tok = tid >> 2, part = tid & 3; const u16* vp = p.proj + (r0 + tok) * NP + C_AV + part * 128;
      u32x4 w[16]; float s = 0.f;
#pragma unroll
      for (int i = 0; i < 16; ++i) { w[i] = *(const u32x4*)(vp + i * 8);
#pragma unroll
          for (int e = 0; e < 4; ++e) s += bflo(w[i][e]) + bfhi(w[i][e]); }
      s += __shfl_xor(s, 1); s += __shfl_xor(s, 2); const float mean = s * (1.f / 512.f);
      float q = 0.f;
#pragma unroll
      for (int i = 0; i < 16; ++i)
#pragma unroll
          for (int e = 0; e < 4; ++e) { const float a = bflo(w[i][e]) - mean, b = bfhi(w[i][e]) - mean; q = fmaf(a, a, q); q = fmaf(b, b, q); }
      q += __shfl_xor(q, 1); q += __shfl_xor(q, 2);
      if (part == 0) { stats[tok * 2] = mean; stats[tok * 2 + 1] = rsqrtf(q * (1.f / 512.f) + EPS); } }
    __syncthreads();
    { const int chn = tid; const float lg = p.gm_ln_g[l * 512 + chn], lb = p.gm_ln_b[l * 512 + chn]; const u16* vp = p.proj + r0 * NP + C_AV + chn;
      LAS unsigned char* vrow = lds + 4096 + chn * 272;
#pragma unroll 4
      for (int s8 = 0; s8 < 16; ++s8) { float v[8];
#pragma unroll
          for (int e = 0; e < 8; ++e) { const int ss = s8 * 8 + e; v[e] = (bf2f(vp[(size_t)ss * NP]) - stats[ss * 2]) * stats[ss * 2 + 1] * lg + lb; }
          u32x4 o = {cvtpk(v[0], v[1]), cvtpk(v[2], v[3]), cvtpk(v[4], v[5]), cvtpk(v[6], v[7])};
          *(LAS u32x4*)(vrow + s8 * 16) = o; } }
    __syncthreads();
    { const int wid = __builtin_amdgcn_readfirstlane(tid >> 6), lane = tid & 63, c32 = lane & 31, hi = lane >> 5, g = wid >> 1, cb2 = wid & 1;
      const float* wsb = p.gm_w_s + ((size_t)(l * 4 + g)) * 128 * 128; const float* bsb = p.gm_b_s + (l * 4 + g) * 128;
      const int ch0 = g * 128 + cb2 * 64 + c32;
      for (int tb = 0; tb < 4; ++tb) {
          f32x16 a0, a1;
#pragma unroll
          for (int r = 0; r < 16; ++r) { a0[r] = 0.f; a1[r] = 0.f; }
          const int trow = tb * 32 + c32;
          for (int sb = 0; sb <= tb; ++sb) {
#pragma unroll
              for (int ks = 0; ks < 2; ++ks) {
                  const int sc0 = sb * 32 + ks * 16 + hi * 8;
                  const f32x4 w0 = *(const f32x4*)(wsb + trow * 128 + sc0), w1 = *(const f32x4*)(wsb + trow * 128 + sc0 + 4);
                  float wv[8] = {w0[0], w0[1], w0[2], w0[3], w1[0], w1[1], w1[2], w1[3]};
#pragma unroll
                  for (int e = 0; e < 8; ++e) if (sc0 + e > trow) wv[e] = 0.f;
                  u32x4 aw = {cvtpk(wv[0], wv[1]), cvtpk(wv[2], wv[3]), cvtpk(wv[4], wv[5]), cvtpk(wv[6], wv[7])};
                  const bf16x8 af = *reinterpret_cast<bf16x8*>(&aw);
                  const bf16x8 b0 = *(const LAS bf16x8*)(lds + 4096 + ch0 * 272 + sc0 * 2);
                  const bf16x8 b1 = *(const LAS bf16x8*)(lds + 4096 + (ch0 + 32) * 272 + sc0 * 2);
                  a0 = __builtin_amdgcn_mfma_f32_32x32x16_bf16(af, b0, a0, 0, 0, 0);
                  a1 = __builtin_amdgcn_mfma_f32_32x32x16_bf16(af, b1, a1, 0, 0, 0);
              }
          }
#pragma unroll
          for (int r = 0; r < 16; ++r) {
              const int t = tb * 32 + (r & 3) + 8 * (r >> 2) + 4 * hi; const float bs = bsb[t];
              const u16* pr = p.proj + (r0 + t) * NP; u16* yr = p.ybuf + ((size_t)0 * MG + r0 + t) * 512;
              { const float uu = bf2f(pr[C_AU + ch0]), zz = bf2f(pr[C_AZ + ch0]); yr[ch0] = f2bf(uu * (a0[r] + bs) * siluf_(zz)); }
              { const float uu = bf2f(pr[C_AU + ch0 + 32]), zz = bf2f(pr[C_AZ + ch0 + 32]); yr[ch0 + 32] = f2bf(uu * (a1[r] + bs) * siluf_(zz)); }
          }
      }
    }
    __syncthreads();
}
__device__ __forceinline__ void item_conv(const Params& p, int l, int it) {
    const int tid = opq(threadIdx.x), cc = tid & 63, tb = tid >> 6; const int r0 = it * 128 + tb * 16, s0 = r0 & 4095;
    float w0[8], w1[8], w2[8];
#pragma unroll
    for (int e = 0; e < 8; ++e) { w0[e] = p.conv_w[(l * 3 + 0) * 512 + cc * 8 + e]; w1[e] = p.conv_w[(l * 3 + 1) * 512 + cc * 8 + e]; w2[e] = p.conv_w[(l * 3 + 2) * 512 + cc * 8 + e]; }
    float y2[8], y1[8];
    auto ld8 = [&](int r, int col, float* o) { const u32x4 w = *(const u32x4*)(p.proj + (size_t)r * NP + col + cc * 8);
#pragma unroll
        for (int e = 0; e < 4; ++e) { o[2 * e] = bflo(w[e]); o[2 * e + 1] = bfhi(w[e]); } };
    auto ycx = [&](int r, float* o) { float a[8], b[8]; ld8(r, C_CC, a); ld8(r, C_CX, b);
#pragma unroll
        for (int e = 0; e < 8; ++e) o[e] = a[e] * b[e]; };
#pragma unroll
    for (int e = 0; e < 8; ++e) { y2[e] = 0.f; y1[e] = 0.f; }
    if (s0 >= 2) ycx(r0 - 2, y2);
    if (s0 >= 1) ycx(r0 - 1, y1);
    for (int i = 0; i < 16; ++i) {
        const int r = r0 + i; float y0[8], bb[8], zz[8], o[8]; ycx(r, y0); ld8(r, C_CB, bb); ld8(r, C_CZ, zz);
#pragma unroll
        for (int e = 0; e < 8; ++e) { o[e] = bb[e] * (w0[e] * y2[e] + w1[e] * y1[e] + w2[e] * y0[e]) * siluf_(zz[e]); y2[e] = y1[e]; y1[e] = y0[e]; }
        u32x4 ow = {cvtpk(o[0], o[1]), cvtpk(o[2], o[3]), cvtpk(o[4], o[5]), cvtpk(o[6], o[7])};
        *(u32x4*)(p.ybuf + ((size_t)2 * MG + r) * 512 + cc * 8) = ow;
    }
}
__device__ __forceinline__ void step_mix(const Params& p, int l, unsigned* ctr, LAS unsigned char* lds, int tmask = 15, int smask = 63) {
    LAS int* sitem = (LAS int*)(lds + ITEM_OFF);
    constexpr int N_D = 256, N_B = 2048, N_A = 128, N_C = 128, N_ALL = N_D + N_B + N_A + N_C;
    const int pref = ((__builtin_amdgcn_s_getreg((3 << 11) | 20) & 3u) != 0u) ? 1 : 0;
    auto fetch = [&]() -> int {
        auto q1 = [&](int i) -> int { return i < N_A + N_C ? N_D + N_B + i : N_D + (i - (N_A + N_C)); };
        if (pref == 0) { int i = (int)atomicAdd(ctr, 1u); if (i < N_D) return i; i = (int)atomicAdd(ctr + 32, 1u); return i < N_ALL - N_D ? q1(i) : N_ALL; }
        int i = (int)atomicAdd(ctr + 32, 1u); if (i < N_ALL - N_D) return q1(i); i = (int)atomicAdd(ctr, 1u); return i < N_D ? i : N_ALL; };
    int nxt = 0;
    if (threadIdx.x == 0) nxt = fetch();
    for (;;) {
        __syncthreads();
        if (threadIdx.x == 0) *sitem = nxt;
        __syncthreads();
        const int it = __builtin_amdgcn_readfirstlane(*sitem);
        if (threadIdx.x == 0 && it < N_ALL) nxt = fetch();
        if (it >= N_ALL) break;
        if (it < N_D) { if (!(tmask & 1)) continue; const int qb = 15 - (it >> 4), bh = it & 15; item_fox(p, l, bh >> 2, bh & 3, qb, lds); }
        else if (it < N_D + N_B) { if (!(tmask & 2)) continue; const int j = it - N_D; const int rq = 511 - (j >> 2), bl = j & 3; item_dsa(p, bl, rq, lds, smask); }
        else if (it < N_D + N_B + N_A) { if (!(tmask & 4)) continue; const int j = it - N_D - N_B; item_gate(p, l, j >> 5, j & 31, lds); }
        else { if (!(tmask & 8)) continue; item_conv(p, l, it - N_D - N_B - N_A); }
    }
}


#define XB_TMO      128
#define XB_XCNT(j)  (256  + 64 * (j))
#define XB_XSUB(j)  (1280 + 64 * (j))
#define XB_XGEN(j)  (2304 + 64 * (j))
#define XB_TOP      3328
#define XB_TOPGEN   3392
#define XCD_BAR_WORDS 3456
#define XB_SPIN_CAP (1u << 22)
__device__ __forceinline__ unsigned xb_ld(unsigned* p)              { return __hip_atomic_load(p, __ATOMIC_RELAXED, __HIP_MEMORY_SCOPE_AGENT); }
__device__ __forceinline__ unsigned xb_add(unsigned* p, unsigned v) { return __hip_atomic_fetch_add(p, v, __ATOMIC_RELAXED, __HIP_MEMORY_SCOPE_AGENT); }
__device__ __forceinline__ unsigned xb_xcc_id() { return (unsigned)__builtin_amdgcn_s_getreg((3 << 11) | 20) & 0xFu; }
#define XB_SPIN(cond, bar) do { unsigned _sp = 0; while (cond) { __builtin_amdgcn_s_sleep(1); \
    if ((++_sp & 255u) == 0u) { if (xb_ld(&(bar)[XB_TMO])) break; if (_sp > XB_SPIN_CAP) { atomicAdd(&(bar)[XB_TMO], 1u); break; } } } } while (0)
struct XcdBarrier { unsigned* bar; unsigned x; volatile LAS unsigned* st; };
__device__ __forceinline__ XcdBarrier xcd_barrier_post(unsigned* bar, volatile LAS unsigned* st) {
    XcdBarrier b; b.bar = bar; b.x = xb_xcc_id(); b.st = st;
    if (threadIdx.x == 0) (void)xb_add(&bar[XB_XCNT(b.x)], 1u);
    return b;
}
__device__ __forceinline__ void xcd_barrier_complete(unsigned* bar, unsigned x, unsigned& nloc, unsigned& nx) {
    const unsigned G = gridDim.x * gridDim.y * gridDim.z;
    unsigned sum, cnt, mine, sp = 0u;
    for (;;) {
        sum = 0u; cnt = 0u; mine = 0u;
#pragma unroll
        for (unsigned j = 0; j < 16; ++j) { const unsigned c = xb_ld(&bar[XB_XCNT(j)]); sum += c; cnt += (c > 0u) ? 1u : 0u; mine = (j == x) ? c : mine; }
        if (sum == G) break;
        __builtin_amdgcn_s_sleep(1);
        if ((++sp & 255u) == 0u) { if (xb_ld(&bar[XB_TMO])) break; if (sp > XB_SPIN_CAP) { atomicAdd(&bar[XB_TMO], 1u); break; } }
    }
    nloc = mine > 0u ? mine : 1u; nx = cnt > 0u ? cnt : 1u;
}
__device__ __forceinline__ void xcd_barrier(const XcdBarrier& b) {
    asm volatile("s_waitcnt vmcnt(0)" ::: "memory");
    __syncthreads();
    if (threadIdx.x == 0) {
        unsigned* bar = b.bar;
        __builtin_amdgcn_s_waitcnt(0);
        unsigned nloc = b.st[0], nx = b.st[1];
        if (nloc == 0u) { xcd_barrier_complete(bar, b.x, nloc, nx); b.st[0] = nloc; b.st[1] = nx; }
        const unsigned old = xb_add(&bar[XB_XSUB(b.x)], 1u);
        const unsigned gen = old / nloc;
        if (old + 1u == (gen + 1u) * nloc) {
            __builtin_amdgcn_fence(__ATOMIC_RELEASE, "agent");
            asm volatile("s_waitcnt vmcnt(0)" ::: "memory");
            const unsigned og = xb_add(&bar[XB_TOP], 1u);
            const unsigned tg = og / nx;
            if (og + 1u == (tg + 1u) * nx) xb_add(&bar[XB_TOPGEN], 1u);
            else XB_SPIN(xb_ld(&bar[XB_TOPGEN]) == tg, bar);
            __builtin_amdgcn_fence(__ATOMIC_ACQUIRE, "agent");
            xb_add(&bar[XB_XGEN(b.x)], 1u);
            asm volatile("s_waitcnt vmcnt(0)" ::: "memory");
        } else {
            XB_SPIN(xb_ld(&bar[XB_XGEN(b.x)]) == gen, bar);
            __builtin_amdgcn_fence(__ATOMIC_ACQUIRE, "agent");
            asm volatile("s_waitcnt vmcnt(0)" ::: "memory");
        }
    }
    __syncthreads();
}

#ifndef REPS
#define REPS 63
#endif
#ifndef REPT
#define REPT 15
#endif
#ifndef REPK
#define REPK 0
#endif
__device__ __forceinline__ void run_step(const Params& p, int s, LAS unsigned char* lds, int rep = 0) {
    if (s == NSTEP - 1) { step_final(p); return; }
    const int l = s / (NGRP * NK), g = (s / NK) % NGRP, k = s % NK;
    if (k == 0) { if (g == 0) step_prep(p, l, lds); step_norm(p, l, g); }
    else if (k == 1) { pg8::Gemm gm{p.hbuf, p.Wt, MG, NP, DM, 1 << 20, 0}; pg8::StaticOrder S; S.init(MG, NP, gridDim.x, blockIdx.x); EpiG1 E{p.proj, p.vT, p.kiP, p.gq}; pg8::gemm_phase(lds, gm, S, E); }
    else if (k == 2) { step_mix(p, l, p.ctr + (l * NGRP + g) + 16 * rep, lds, rep ? REPT : 15, rep ? REPS : 63); }
    else if (k == 3) { pg8::Gemm gm{p.ybuf, p.Wb, MG, 4096, 512, 4, (size_t)MG * 512 * 2}; pg8::BranchOrder S{(int)gridDim.x, (int)blockIdx.x, (MG / 256) * 4}; EpiG2 E{p.gq, p.hbuf}; pg8::gemm_phase(lds, gm, S, E); }
    else { pg8::Gemm gm{p.hbuf, p.Wo, MG, DM, DM, 1 << 20, 0}; pg8::StaticOrder S; S.init(MG, DM, gridDim.x, blockIdx.x); EpiG3 E{(l == 0) ? p.x : p.out, rep ? (float*)p.proj - (size_t)g * MG * DM : p.out, g * MG}; pg8::gemm_phase(lds, gm, S, E); }
}
__global__ __launch_bounds__(512, 2) void mega(Params p, int s0, int s1) {
    extern __shared__ __attribute__((aligned(16))) unsigned char shm[];
    LAS unsigned char* lds = (LAS unsigned char*)shm;
    cg::grid_group grid = cg::this_grid();
    volatile LAS unsigned* st = (volatile LAS unsigned*)(lds + XB_ST_OFF);
    if (threadIdx.x == 0) { st[0] = 0u; st[1] = 0u; }
    __syncthreads();
    const XcdBarrier xb = xcd_barrier_post(p.bar, st);
    for (int s = s0; s < s1; ++s) { run_step(p, s, lds);
        if (s + 1 < s1) { if (s1 < 0) grid.sync(); else xcd_barrier(xb); } }
}

extern "C" void kernel_launch(void* const* d_in, const int* in_sizes, int n_in, void* d_out, int out_size, void* d_ws, size_t ws_size, hipStream_t stream) {
    static int grid = 0;
    if (grid == 0) {
        int dev = 0, cus = 0, per_cu = 0;
        hipGetDevice(&dev); hipDeviceGetAttribute(&cus, hipDeviceAttributeMultiprocessorCount, dev);
        hipFuncSetAttribute((const void*)mega, hipFuncAttributeMaxDynamicSharedMemorySize, LDS_BYTES);
        hipOccupancyMaxActiveBlocksPerMultiprocessor(&per_cu, (const void*)mega, 512, LDS_BYTES);
        if (per_cu < 1) per_cu = 1;
        grid = cus * per_cu;
    }
    Params p{};
    const float** f = (const float**)&p;
    for (int i = 0; i < 15; ++i) f[i] = (const float*)d_in[i];
    p.out = (float*)d_out;
    unsigned char* w = (unsigned char*)d_ws; size_t o = 0;
    auto take = [&](size_t bytes) { unsigned char* r = w + o; o += (bytes + 255) & ~(size_t)255; return r; };
    p.ctr = (unsigned*)take(256); p.bar = (unsigned*)take((size_t)XCD_BAR_WORDS * 4);
    p.Wt = (u16*)take((size_t)NP * DM * 2); p.Wb = (u16*)take((size_t)4096 * 512 * 2); p.Wo = (u16*)take((size_t)DM * DM * 2); p.WuvT = (u16*)take((size_t)4 * 128 * 128 * 2);
    p.hbuf = (u16*)take((size_t)MG * DM * 2); p.ybuf = (u16*)take((size_t)4 * MG * 512 * 2); p.vT = (u16*)take((size_t)BG * 4 * 128 * 4096 * 2);
    p.kiP = (u16*)take((size_t)BG * 4096 * 64 * 2);
    p.gq = (unsigned char*)take((size_t)MG * 4096);
    p.proj = (u16*)take((size_t)MG * NP * 2);
    if (o > ws_size) { fprintf(stderr, "workspace too small: need %zu have %zu\n", o, ws_size); return; }
    hipMemsetAsync(p.ctr, 0, 256 + (size_t)XCD_BAR_WORDS * 4, stream);
#if FUSED
    int s0 = 0, s1 = NSTEP; void* args[] = {&p, &s0, &s1};
    hipError_t e = hipLaunchCooperativeKernel((const void*)mega, dim3(grid), dim3(512), args, LDS_BYTES, stream);
    if (e != hipSuccess) fprintf(stderr, "cooperative launch failed: %s (grid %d)\n", hipGetErrorString(e), grid);
#else
    for (int s = 0; s < NSTEP; ++s) hipLaunchKernelGGL(mega, dim3(grid), dim3(512), LDS_BYTES, stream, p, s, s + 1);
#endif
}
```
